# Optimizing an MI355X kernel written in HIP

```python
import jax, jax.numpy as jnp
from jax import lax
import numpy as np

D_MODEL = 1024
BATCH = 2
SEQ = 8192
DEPTH = 2

EXPAND = 2
D_INNER = EXPAND * D_MODEL
EPS = 1e-6
NEG = -1e30

A_WIDTH = D_INNER // 2
POOL_SIZES = (2, 4, 8, 16)
A_GROUPS = len(POOL_SIZES)
A_GROUP_DIM = A_WIDTH // A_GROUPS
B_WIDTH = D_INNER - A_WIDTH
B_GROUPS = 4
B_GROUP_DIM = B_WIDTH // B_GROUPS
CHUNK = 128
EVEN_IN = 2 * A_WIDTH + 3 * B_WIDTH

DILATED = ((128, 1), (512, 4), (2048, 16))
N_DIL = len(DILATED)
HEAD_DIM = 128
C_SLOTS = 8
C_HEADS = C_SLOTS * N_DIL
C_WIDTH = C_SLOTS * HEAD_DIM
D_WIDTH = D_INNER - C_WIDTH
CONV_W = 3
ATTN_BLOCK = 128
QKV_WIDTH = 3 * C_HEADS * HEAD_DIM
ODD_IN = QKV_WIDTH + C_WIDTH + 4 * D_WIDTH

N_EVEN = (DEPTH + 1) // 2
N_ODD = DEPTH // 2

kernel_name = "hybrid_pool_gmlp_dilattn_shortconv"


def rmsnorm(x, g):
    xf = x.astype(jnp.float32)
    y = xf * lax.rsqrt(jnp.mean(xf * xf, axis=-1, keepdims=True) + EPS)
    return (y * g.astype(jnp.float32)).astype(x.dtype)


def alibi_slopes(n):
    return jnp.asarray(2.0 ** (-8.0 * (np.arange(n) + 1) / n), dtype=jnp.float32)


def multiscale_pool(a, pool_w, pool_scale):
    Bn, S, _ = a.shape
    ag = a.reshape(Bn, S, A_GROUPS, A_GROUP_DIM).astype(jnp.float32)
    cs = jnp.pad(jnp.cumsum(ag, axis=1), ((0, 0), (1, 0), (0, 0), (0, 0)))
    t = jnp.arange(S)
    means = []
    for g, w in enumerate(POOL_SIZES):
        lo = jnp.maximum(t + 1 - w, 0)
        cnt = (t + 1 - lo).astype(jnp.float32)
        means.append((cs[:, 1:, g] - cs[:, lo, g]) / cnt[None, :, None])
    pooled = (jnp.stack(means, axis=2) - ag).astype(a.dtype)
    mixed = jnp.einsum('bsgc,gcd->bsgd', pooled, pool_w)
    return mixed.reshape(Bn, S, A_WIDTH) * pool_scale


def chunk_spatial_gate(u, v, ws, bs):
    Bn, S, _ = v.shape
    nc = S // CHUNK
    vg = v.reshape(Bn, nc, CHUNK, B_GROUPS, B_GROUP_DIM)
    causal = jnp.tril(jnp.ones((CHUNK, CHUNK), dtype=bool))
    w = jnp.where(causal[None], ws, jnp.zeros_like(ws))
    mixed = jnp.einsum('gts,bnsgc->bntgc', w, vg) + bs.T[None, None, :, :, None]
    return u * mixed.reshape(Bn, S, B_WIDTH)


def dilated_group_attention(q, k, v, window, dilation, slopes):
    Bn, S, H, Dh = q.shape
    unit = dilation * ATTN_BLOCK
    Sp = -(-S // unit) * unit
    pad = Sp - S
    L = Sp // dilation
    nb = L // ATTN_BLOCK
    span = window // dilation

    def to_sub(x):
        x = jnp.pad(x, ((0, 0), (0, pad), (0, 0), (0, 0)))
        return x.reshape(Bn, L, dilation, H, Dh).transpose(0, 2, 1, 3, 4)

    def band(x):
        x = jnp.pad(x, ((0, 0), (0, 0), (ATTN_BLOCK, 0), (0, 0), (0, 0)))
        x = x.reshape(Bn, dilation, nb + 1, ATTN_BLOCK, H, Dh)
        return jnp.concatenate([x[:, :, :-1], x[:, :, 1:]], axis=3)

    qb = to_sub(q).reshape(Bn, dilation, nb, ATTN_BLOCK, H, Dh)
    kb = band(to_sub(k))
    vb = band(to_sub(v))
    s = jnp.einsum('bdnqhe,bdnkhe->bdnhqk', qb, kb,
                   preferred_element_type=jnp.float32) * (Dh ** -0.5)
    qi = jnp.arange(ATTN_BLOCK)[:, None] + ATTN_BLOCK
    ki = jnp.arange(2 * ATTN_BLOCK)[None, :]
    steps = qi - ki
    band_ok = (steps >= 0) & (steps <= span)
    blk = jnp.arange(nb)[:, None, None]
    valid = band_ok[None] & ((blk > 0) | (ki >= ATTN_BLOCK)[None])
    dist = (steps * dilation).astype(jnp.float32)
    s = s - slopes[:, None, None] * dist
    s = jnp.where(valid[:, None], s, NEG)
    lse = jax.nn.logsumexp(s, axis=-1)
    p = jnp.exp(s - lse[..., None])
    o = jnp.einsum('bdnhqk,bdnkhe->bdnqhe', p.astype(v.dtype), vb)
    o = o.reshape(Bn, dilation, L, H, Dh).transpose(0, 2, 1, 3, 4).reshape(Bn, Sp, H, Dh)[:, :S]
    lse = lse.transpose(0, 1, 2, 4, 3).reshape(Bn, dilation, L, H)
    lse = lse.transpose(0, 2, 1, 3).reshape(Bn, Sp, H)[:, :S]
    return o, lse


def short_gated_conv(gb, gc, xt, conv_w):
    S = xt.shape[1]
    z = jnp.pad(gc * xt, ((0, 0), (CONV_W - 1, 0), (0, 0)))
    conv = conv_w[0] * z[:, 0:S]
    for j in range(1, CONV_W):
        conv = conv + conv_w[j] * z[:, j:j + S]
    return gb * conv


def even_layer(x, norm_g, w_in, pool_w, pool_scale, ws, bs, w_out):
    h = rmsnorm(x, norm_g)
    z = h @ w_in
    a, g_a, u, v, g_b = jnp.split(
        z, [A_WIDTH, 2 * A_WIDTH, 2 * A_WIDTH + B_WIDTH, 2 * A_WIDTH + 2 * B_WIDTH], axis=-1)
    y_a = multiscale_pool(a, pool_w, pool_scale) * jax.nn.silu(g_a)
    y_b = chunk_spatial_gate(u, v, ws, bs) * jax.nn.silu(g_b)
    return x + jnp.concatenate([y_a, y_b], axis=-1) @ w_out


def odd_layer(x, norm_g, w_in, conv_w, w_out):
    Bn, S, _ = x.shape
    h = rmsnorm(x, norm_g)
    z = h @ w_in
    o1 = QKV_WIDTH
    o2 = o1 + C_WIDTH
    qkv, g_c, d_b, d_c, d_x, g_d = jnp.split(
        z, [o1, o2, o2 + D_WIDTH, o2 + 2 * D_WIDTH, o2 + 3 * D_WIDTH], axis=-1)
    qkv = qkv.reshape(Bn, S, 3, N_DIL, C_SLOTS, HEAD_DIM)
    slopes = alibi_slopes(C_HEADS).reshape(N_DIL, C_SLOTS)
    outs, lses = [], []
    for gi, (window, dil) in enumerate(DILATED):
        o, l = dilated_group_attention(qkv[:, :, 0, gi], qkv[:, :, 1, gi], qkv[:, :, 2, gi],
                                       window, dil, slopes[gi])
        outs.append(o)
        lses.append(l)
    alpha = jax.nn.softmax(jnp.stack(lses, axis=0), axis=0)
    y_c = jnp.einsum('gbsh,gbshe->bshe', alpha.astype(x.dtype), jnp.stack(outs, axis=0))
    y_c = y_c.reshape(Bn, S, C_WIDTH) * jax.nn.silu(g_c)
    y_d = short_gated_conv(d_b, d_c, d_x, conv_w) * jax.nn.silu(g_d)
    return x + jnp.concatenate([y_c, y_d], axis=-1) @ w_out


def setup_inputs(seed: int = 0) -> dict:
    key = jax.random.key(seed)
    ks = jax.random.split(key, 16)
    nrm = jax.random.normal
    f32 = jnp.float32
    return {
        "x": nrm(ks[0], (BATCH, SEQ, D_MODEL), f32),
        "even_norm": 1.0 + 0.05 * nrm(ks[1], (N_EVEN, D_MODEL), f32),
        "even_w_in": nrm(ks[2], (N_EVEN, D_MODEL, EVEN_IN), f32) * D_MODEL ** -0.5,
        "even_pool_w": nrm(ks[3], (N_EVEN, A_GROUPS, A_GROUP_DIM, A_GROUP_DIM), f32) * A_GROUP_DIM ** -0.5,
        "even_pool_scale": 1.0 + 0.1 * nrm(ks[4], (N_EVEN, A_WIDTH), f32),
        "even_ws": nrm(ks[5], (N_EVEN, B_GROUPS, CHUNK, CHUNK), f32) * CHUNK ** -0.5,
        "even_bs": 1.0 + 0.1 * nrm(ks[6], (N_EVEN, B_GROUPS, CHUNK), f32),
        "even_w_out": nrm(ks[7], (N_EVEN, D_INNER, D_MODEL), f32) * D_INNER ** -0.5,
        "odd_norm": 1.0 + 0.05 * nrm(ks[8], (N_ODD, D_MODEL), f32),
        "odd_w_in": nrm(ks[9], (N_ODD, D_MODEL, ODD_IN), f32) * D_MODEL ** -0.5,
        "odd_conv_w": nrm(ks[10], (N_ODD, CONV_W, D_WIDTH), f32) * CONV_W ** -0.5,
        "odd_w_out": nrm(ks[11], (N_ODD, D_INNER, D_MODEL), f32) * D_INNER ** -0.5,
        "final_norm": 1.0 + 0.05 * nrm(ks[12], (D_MODEL,), f32),
    }


def reference(x, even_norm, even_w_in, even_pool_w, even_pool_scale, even_ws, even_bs,
              even_w_out, odd_norm, odd_w_in, odd_conv_w, odd_w_out, final_norm):
    h = x
    for layer in range(DEPTH):
        i = layer // 2
        if layer % 2 == 0:
            h = even_layer(h, even_norm[i], even_w_in[i], even_pool_w[i], even_pool_scale[i],
                           even_ws[i], even_bs[i], even_w_out[i])
        else:
            h = odd_layer(h, odd_norm[i], odd_w_in[i], odd_conv_w[i], odd_w_out[i])
    return rmsnorm(h, final_norm)
```

```cpp
#define NAIVE_ATTN 0

#include <hip/hip_runtime.h>
#include <hip/hip_cooperative_groups.h>
#include <cstdio>
#include <cstdint>
namespace cg = cooperative_groups;

#define LAS __attribute__((address_space(3)))
typedef unsigned short bf16_t;
typedef short bf16x8 __attribute__((ext_vector_type(8)));
typedef short s16x4 __attribute__((ext_vector_type(4)));
typedef float f32x4 __attribute__((ext_vector_type(4)));
typedef float f32x2 __attribute__((ext_vector_type(2)));
typedef unsigned u32x4 __attribute__((ext_vector_type(4)));
typedef unsigned u32x2 __attribute__((ext_vector_type(2)));

constexpr int M_TOK = 16384, SEQ = 8192, DM = 1024;
constexpr int EVEN_IN = 5120, ODD_IN = 14336, DI = 2048, ZP = 4096;
constexpr float EPS = 1e-6f;
constexpr size_t MiB = 1u << 20;
constexpr size_t WS_W1T = 0, WS_W2T = 10 * MiB, WS_W3T = 14 * MiB, WS_W4T = 42 * MiB, WS_WSB = 46 * MiB, WS_LSE = 47 * MiB;
constexpr size_t WS_XN = 48 * MiB, WS_X1 = 80 * MiB, WS_Z1 = 80 * MiB, WS_QKV = 144 * MiB, WS_Y2 = 144 * MiB, WS_GB = 208 * MiB;
constexpr int LDS_BYTES = 147456;

typedef __bf16 bf16x2_t __attribute__((ext_vector_type(2)));
__device__ __forceinline__ unsigned cvt_pk_bf16(float lo, float hi) { f32x2 v = {lo, hi}; bf16x2_t b = __builtin_convertvector(v, bf16x2_t); return __builtin_bit_cast(unsigned, b); }
__device__ __forceinline__ float bf_lo(unsigned u) { return __uint_as_float(u << 16); }
__device__ __forceinline__ float bf_hi(unsigned u) { return __uint_as_float(u & 0xffff0000u); }
__device__ __forceinline__ float silu_f(float x) { return x * __builtin_amdgcn_rcpf(1.0f + __expf(-x)); }
__device__ __forceinline__ float wave_sum(float v) {
#pragma unroll
    for (int o = 1; o < 64; o <<= 1) v += __shfl_xor(v, o);
    return v;
}
__device__ __forceinline__ s16x4 tr_read(const LAS unsigned char* p) {
    typedef short v4i16_t __attribute__((ext_vector_type(4)));
    return __builtin_bit_cast(s16x4, __builtin_amdgcn_ds_read_tr16_b64_v4i16((LAS v4i16_t*)p));
}
__device__ __forceinline__ bf16x8 cat8(s16x4 lo, s16x4 hi) { return (bf16x8){lo[0], lo[1], lo[2], lo[3], hi[0], hi[1], hi[2], hi[3]}; }

namespace pg8 {
constexpr int BM = 256, BK = 64, HALF = 128, HTB = HALF * BK * 2, STAGE_BYTES = 8 * HTB, NXCD = 8, WGM = 8;
__host__ __device__ __forceinline__ int lds_byte(int r, int c) { const int st = (r >> 4) * 2 + (c >> 5), rr = r & 15, cc = c & 31, ob = rr * 64 + cc * 2; return st * 1024 + (ob ^ (((ob >> 9) & 1) << 5)); }
__host__ __device__ __forceinline__ void stage_rc(int b, int& R, int& C) { const int st = b / 1024, sb = b % 1024, swz = sb ^ (((sb >> 9) & 1) << 5); R = (st >> 1) * 16 + swz / 64; C = (st & 1) * 32 + (swz % 64) / 2; }
__host__ __device__ __forceinline__ int perm32(int rho) { const int n = rho >> 4, i = rho & 15; return 8 * (i >> 2) + 4 * n + (i & 3); }

struct Unit { int pm, pn; };
struct Gemm { const bf16_t* A; const bf16_t* Bt; int M, N, K; };

struct StaticOrder {
    int nM, nN, nwg, G, c;
    __host__ __device__ void init(int M, int N, int G_, int c_) { nM = M / BM; nN = N / BM; nwg = nM * nN; G = G_; c = c_; }
    __host__ __device__ bool next(int i, Unit& u) const {
        const long L = (long)i * G + c; if (L >= nwg) return false;
        int wgid = (int)L; { const int q = nwg / NXCD, r = nwg % NXCD, xcd = wgid % NXCD, off = wgid / NXCD; wgid = (xcd < r ? xcd * (q + 1) : r * (q + 1) + (xcd - r) * q) + off; }
        const int nig = WGM * nN, gid = wgid / nig, fm = gid * WGM, gsz = (nM - fm) < WGM ? (nM - fm) : WGM;
        u.pm = fm + ((wgid % nig) % gsz); u.pn = (wgid % nig) / gsz; return true;
    }
};

struct EpiBf16 {
    static constexpr bool AFTER_DRAIN = false; static constexpr bool HAS_INIT = false;
    static constexpr bool PERM = true;
    bf16_t* O; int ldc; const float* rs;
    __device__ __forceinline__ void operator()(const f32x4 (&acc)[2][2][4][2], const Unit& u, int wr, int wc, int fr, int fq) const {
        const int row0 = u.pm * BM + wr * 64 + fr; const int col0 = u.pn * BM + wc * 32 + 8 * fq;
#pragma unroll
        for (int ai = 0; ai < 2; ++ai)
#pragma unroll
            for (int m = 0; m < 4; ++m) { bf16_t* rowp = O + (size_t)(row0 + ai * HALF + m * 16) * ldc + col0; const float r = rs[row0 + ai * HALF + m * 16];
#pragma unroll
                for (int bj = 0; bj < 2; ++bj) { const f32x4 v0 = acc[ai][bj][m][0] * r, v1 = acc[ai][bj][m][1] * r;
                    u32x4 w; w.x = cvt_pk_bf16(v0[0], v0[1]); w.y = cvt_pk_bf16(v0[2], v0[3]); w.z = cvt_pk_bf16(v1[0], v1[1]); w.w = cvt_pk_bf16(v1[2], v1[3]);
                    *(u32x4*)(rowp + bj * HALF) = w; } }
    }
};
struct EpiResF32 {
    static constexpr bool AFTER_DRAIN = false; static constexpr bool HAS_INIT = false;
    static constexpr bool PERM = false;
    const float* base; float* out; int ldc;
    __device__ __forceinline__ void operator()(const f32x4 (&acc)[2][2][4][2], const Unit& u, int wr, int wc, int fr, int fq) const {
        const int col0 = u.pn * BM + wc * 32 + 4 * fq;
#pragma unroll
        for (int ai = 0; ai < 2; ++ai)
#pragma unroll
            for (int m = 0; m < 4; ++m) { const size_t off = (size_t)(u.pm * BM + ai * HALF + wr * 64 + m * 16 + fr) * ldc + col0;
#pragma unroll
                for (int bj = 0; bj < 2; ++bj)
#pragma unroll
                    for (int n = 0; n < 2; ++n) { const f32x4 bs = *(const f32x4*)(base + off + bj * HALF + n * 16); *(f32x4*)(out + off + bj * HALF + n * 16) = bs + acc[ai][bj][m][n]; } }
    }
};
struct EpiGateMul {
    static constexpr bool AFTER_DRAIN = false; static constexpr bool HAS_INIT = false;
    static constexpr bool PERM = true;
    const bf16_t* Oin; int ldo; bf16_t* Y; int ldy; const float* rs;
    __device__ __forceinline__ void operator()(const f32x4 (&acc)[2][2][4][2], const Unit& u, int wr, int wc, int fr, int fq) const {
        const int row0 = u.pm * BM + wr * 64 + fr; const int col0 = u.pn * BM + wc * 32 + 8 * fq;
#pragma unroll
        for (int ai = 0; ai < 2; ++ai)
#pragma unroll
            for (int m = 0; m < 4; ++m) { const size_t row = (size_t)(row0 + ai * HALF + m * 16); const float r = rs[row];
#pragma unroll
                for (int bj = 0; bj < 2; ++bj) { const f32x4 v0 = acc[ai][bj][m][0] * r, v1 = acc[ai][bj][m][1] * r;
                    const u32x4 o = *(const u32x4*)(Oin + row * ldo + col0 + bj * HALF);
                    u32x4 w;
                    w.x = cvt_pk_bf16(bf_lo(o.x) * silu_f(v0[0]), bf_hi(o.x) * silu_f(v0[1])); w.y = cvt_pk_bf16(bf_lo(o.y) * silu_f(v0[2]), bf_hi(o.y) * silu_f(v0[3]));
                    w.z = cvt_pk_bf16(bf_lo(o.z) * silu_f(v1[0]), bf_hi(o.z) * silu_f(v1[1])); w.w = cvt_pk_bf16(bf_lo(o.w) * silu_f(v1[2]), bf_hi(o.w) * silu_f(v1[3]));
                    *(u32x4*)(Y + row * ldy + col0 + bj * HALF) = w; } }
    }
};
struct EpiPair {
    static constexpr bool AFTER_DRAIN = false; static constexpr bool HAS_INIT = false;
    static constexpr bool PERM = true;
    bf16_t* ZC; bf16_t* GB; const float* rs;
    __device__ __forceinline__ void operator()(const f32x4 (&acc)[2][2][4][2], const Unit& u, int wr, int wc, int fr, int fq) const {
        const int row0 = u.pm * BM + wr * 64 + fr; const bool gate = u.pn >= 8; const int ct = gate ? u.pn - 8 : u.pn;
        bf16_t* dst = (gate ? GB : ZC) + ct * 128 + wc * 32 + 8 * fq;
#pragma unroll
        for (int ai = 0; ai < 2; ++ai)
#pragma unroll
            for (int m = 0; m < 4; ++m) { const size_t row = (size_t)(row0 + ai * HALF + m * 16);
                const float r = rs[row];
                f32x4 p0 = acc[ai][0][m][0] * r, p1 = acc[ai][0][m][1] * r, q0 = acc[ai][1][m][0] * r, q1 = acc[ai][1][m][1] * r;
                if (gate) {
#pragma unroll
                    for (int e = 0; e < 4; ++e) { q0[e] = silu_f(q0[e]); q1[e] = silu_f(q1[e]); } }
                p0 = p0 * q0; p1 = p1 * q1;
                u32x4 w; w.x = cvt_pk_bf16(p0[0], p0[1]); w.y = cvt_pk_bf16(p0[2], p0[3]); w.z = cvt_pk_bf16(p1[0], p1[1]); w.w = cvt_pk_bf16(p1[2], p1[3]);
                *(u32x4*)(dst + row * 1024) = w; }
    }
};


struct EpiGateConv {
    static constexpr bool AFTER_DRAIN = false; static constexpr bool HAS_INIT = false;
    static constexpr bool PERM = true;
    const bf16_t* ZC; const float* cw; bf16_t* Y2; const float* rs;
    __device__ __forceinline__ void operator()(const f32x4 (&acc)[2][2][4][2], const Unit& u, int wr, int wc, int fr, int fq) const {
        const int row0 = u.pm * BM + wr * 64 + fr; const int ch0 = u.pn * 128 + wc * 32 + 8 * fq;
        const f32x4 wa0 = *(const f32x4*)(cw + ch0), wa1 = *(const f32x4*)(cw + ch0 + 4), wb0 = *(const f32x4*)(cw + 1024 + ch0), wb1 = *(const f32x4*)(cw + 1024 + ch0 + 4),
                    wc0 = *(const f32x4*)(cw + 2048 + ch0), wc1 = *(const f32x4*)(cw + 2048 + ch0 + 4);
#pragma unroll
        for (int ai = 0; ai < 2; ++ai)
#pragma unroll
            for (int m = 0; m < 4; ++m) { const int row = row0 + ai * HALF + m * 16; const int tl = row & (SEQ - 1);
                const bf16_t* zp = ZC + (size_t)row * 1024 + ch0;
                const u32x4 z0 = *(const u32x4*)zp;
                const u32x4 z1 = (tl >= 1) ? *(const u32x4*)(zp - 1024) : (u32x4){0u, 0u, 0u, 0u};
                const u32x4 z2 = (tl >= 2) ? *(const u32x4*)(zp - 2048) : (u32x4){0u, 0u, 0u, 0u};
                const float r = rs[row];
                f32x4 p0 = acc[ai][0][m][0] * r, p1 = acc[ai][0][m][1] * r; const f32x4 q0 = acc[ai][1][m][0] * r, q1 = acc[ai][1][m][1] * r;
#pragma unroll
                for (int e = 0; e < 4; ++e) { p0[e] *= silu_f(q0[e]); p1[e] *= silu_f(q1[e]); }
                const f32x4 a0 = {bf_lo(z0.x), bf_hi(z0.x), bf_lo(z0.y), bf_hi(z0.y)}, a1 = {bf_lo(z0.z), bf_hi(z0.z), bf_lo(z0.w), bf_hi(z0.w)};
                const f32x4 b0 = {bf_lo(z1.x), bf_hi(z1.x), bf_lo(z1.y), bf_hi(z1.y)}, b1 = {bf_lo(z1.z), bf_hi(z1.z), bf_lo(z1.w), bf_hi(z1.w)};
                const f32x4 c0 = {bf_lo(z2.x), bf_hi(z2.x), bf_lo(z2.y), bf_hi(z2.y)}, c1 = {bf_lo(z2.z), bf_hi(z2.z), bf_lo(z2.w), bf_hi(z2.w)};
                p0 = p0 * (wa0 * c0 + wb0 * b0 + wc0 * a0); p1 = p1 * (wa1 * c1 + wb1 * b1 + wc1 * a1);
                u32x4 w; w.x = cvt_pk_bf16(p0[0], p0[1]); w.y = cvt_pk_bf16(p0[2], p0[3]); w.z = cvt_pk_bf16(p1[0], p1[1]); w.w = cvt_pk_bf16(p1[2], p1[3]);
                *(u32x4*)(Y2 + (size_t)row * DI + 1024 + ch0) = w; }
    }
};

struct EpiQkvZc {
    static constexpr bool AFTER_DRAIN = false, PERM = true, HAS_INIT = false;
    EpiBf16 e0; EpiPair e1;
    __device__ __forceinline__ void operator()(const f32x4 (&acc)[2][2][4][2], const Unit& u, int wr, int wc, int fr, int fq) const {
        if (u.pn < 12) e0(acc, u, wr, wc, fr, fq); else { Unit v = u; v.pn -= 12; e1(acc, v, wr, wc, fr, fq); }
    }
};
struct EpiGcGb {
    static constexpr bool AFTER_DRAIN = false, PERM = true, HAS_INIT = false;
    EpiGateMul e0; EpiGateConv e1;
    __device__ __forceinline__ void operator()(const f32x4 (&acc)[2][2][4][2], const Unit& u, int wr, int wc, int fr, int fq) const {
        if (u.pn < 4) e0(acc, u, wr, wc, fr, fq); else { Unit v = u; v.pn -= 4; e1(acc, v, wr, wc, fr, fq); }
    }
};

struct EpiEven {
    static constexpr bool AFTER_DRAIN = false, PERM = true, HAS_INIT = false;
    bf16_t* Z;
    __device__ __forceinline__ void operator()(const f32x4 (&acc)[2][2][4][2], const Unit& u, int wr, int wc, int fr, int fq) const {
        const int row0 = u.pm * BM + wr * 64 + fr;
        if (u.pn < 12) {
            const bool act = (u.pn >= 4) && (u.pn < 8); const int col0 = u.pn * BM + wc * 32 + 8 * fq;
#pragma unroll
            for (int ai = 0; ai < 2; ++ai)
#pragma unroll
                for (int m = 0; m < 4; ++m) { bf16_t* rowp = Z + (size_t)(row0 + ai * HALF + m * 16) * ZP + col0;
#pragma unroll
                    for (int bj = 0; bj < 2; ++bj) { f32x4 v0 = acc[ai][bj][m][0], v1 = acc[ai][bj][m][1];
                        if (act) {
#pragma unroll
                            for (int e = 0; e < 4; ++e) { v0[e] = silu_f(v0[e]); v1[e] = silu_f(v1[e]); } }
                        u32x4 w; w.x = cvt_pk_bf16(v0[0], v0[1]); w.y = cvt_pk_bf16(v0[2], v0[3]); w.z = cvt_pk_bf16(v1[0], v1[1]); w.w = cvt_pk_bf16(v1[2], v1[3]);
                        *(u32x4*)(rowp + bj * HALF) = w; } }
        } else {
            bf16_t* dst = Z + 3072 + (u.pn - 12) * 128 + wc * 32 + 8 * fq;
#pragma unroll
            for (int ai = 0; ai < 2; ++ai)
#pragma unroll
                for (int m = 0; m < 4; ++m) { const size_t row = (size_t)(row0 + ai * HALF + m * 16);
                    f32x4 p0 = acc[ai][0][m][0], p1 = acc[ai][0][m][1]; const f32x4 q0 = acc[ai][1][m][0], q1 = acc[ai][1][m][1];
#pragma unroll
                    for (int e = 0; e < 4; ++e) { p0[e] *= silu_f(q0[e]); p1[e] *= silu_f(q1[e]); }
                    u32x4 w; w.x = cvt_pk_bf16(p0[0], p0[1]); w.y = cvt_pk_bf16(p0[2], p0[3]); w.z = cvt_pk_bf16(p1[0], p1[1]); w.w = cvt_pk_bf16(p1[2], p1[3]);
                    *(u32x4*)(dst + row * ZP) = w; }
        }
    }
};

struct PanelSq {
    float* xbuf;
    unsigned* cnt;
    __device__ __forceinline__ void run(const f32x4 (&v)[2][2][4][2], const Unit& u, int wr, int wc, int fr, int fq, LAS unsigned char* lds, int wid, int lane) const {
        LAS float* P = (LAS float*)lds;
        LAS float* S = (LAS float*)(lds + 4096);
#pragma unroll
        for (int ai = 0; ai < 2; ++ai)
#pragma unroll
            for (int m = 0; m < 4; ++m) {
                float q = 0.f;
#pragma unroll
                for (int bj = 0; bj < 2; ++bj)
#pragma unroll
                    for (int n = 0; n < 2; ++n) { const f32x4 x = v[ai][bj][m][n]; q += (x[0] * x[0] + x[1] * x[1]) + (x[2] * x[2] + x[3] * x[3]); }
                q += __shfl_xor(q, 16); q += __shfl_xor(q, 32);
                if (fq == 0) P[(ai * HALF + wr * 64 + m * 16 + fr) * 4 + wc] = q;
            }
        asm volatile("s_waitcnt lgkmcnt(0)" ::: "memory"); __builtin_amdgcn_s_barrier(); asm volatile("" ::: "memory");
        const int row = wid * 64 + lane;
        if (wid < 4) {
            const float tot = (P[row * 4 + 0] + P[row * 4 + 1]) + (P[row * 4 + 2] + P[row * 4 + 3]);
            __hip_atomic_store(xbuf + (size_t)(u.pm * BM + row) * 4 + u.pn, tot, __ATOMIC_RELAXED, __HIP_MEMORY_SCOPE_AGENT);
        }
        asm volatile("s_waitcnt vmcnt(0)" ::: "memory");
        if (wid < 4 && lane == 0) __hip_atomic_fetch_add(cnt + 64 * u.pm, 1u, __ATOMIC_RELAXED, __HIP_MEMORY_SCOPE_AGENT);
        if (wid == 0) {
            unsigned sp = 0;
            while ((unsigned)__builtin_amdgcn_readfirstlane(__hip_atomic_load(cnt + 64 * u.pm, __ATOMIC_RELAXED, __HIP_MEMORY_SCOPE_AGENT)) < 16u) { __builtin_amdgcn_s_sleep(2); if (++sp > (1u << 22)) break; }
            __builtin_amdgcn_fence(__ATOMIC_ACQUIRE, "agent");
        }
        asm volatile("s_waitcnt vmcnt(0) lgkmcnt(0)" ::: "memory"); __builtin_amdgcn_s_barrier(); asm volatile("" ::: "memory");
        if (wid < 4) {
            const float* slot = xbuf + (size_t)(u.pm * BM + row) * 4;
            const float a0 = __hip_atomic_load(slot + 0, __ATOMIC_RELAXED, __HIP_MEMORY_SCOPE_AGENT), a1 = __hip_atomic_load(slot + 1, __ATOMIC_RELAXED, __HIP_MEMORY_SCOPE_AGENT);
            const float a2 = __hip_atomic_load(slot + 2, __ATOMIC_RELAXED, __HIP_MEMORY_SCOPE_AGENT), a3 = __hip_atomic_load(slot + 3, __ATOMIC_RELAXED, __HIP_MEMORY_SCOPE_AGENT);
            S[row] = rsqrtf(((a0 + a1) + (a2 + a3)) * (1.f / 1024.f) + 1e-6f);
        }
        asm volatile("s_waitcnt lgkmcnt(0)" ::: "memory"); __builtin_amdgcn_s_barrier(); asm volatile("" ::: "memory");
    }
};
template <bool WRITE_X  >
struct EpiResNorm {
    static constexpr bool PERM = true, AFTER_DRAIN = true, HAS_INIT = true; static constexpr int NSTORES = 0;
    const float* base; const bf16_t* base16; bf16_t* xout; float* rs; float* nout; const float* g; PanelSq st;
    __device__ __forceinline__ void init(f32x4 (&acc)[2][2][4][2], const Unit& u, int wr, int wc, int fr, int fq) const {
        const int col0 = u.pn * BM + wc * 32 + 8 * fq;
#pragma unroll
        for (int ai = 0; ai < 2; ++ai)
#pragma unroll
            for (int m = 0; m < 4; ++m) { const size_t off = (size_t)(u.pm * BM + ai * HALF + wr * 64 + m * 16 + fr) * 1024 + col0;
#pragma unroll
                for (int bj = 0; bj < 2; ++bj) {
                    if (WRITE_X) { acc[ai][bj][m][0] = *(const f32x4*)(base + off + bj * HALF); acc[ai][bj][m][1] = *(const f32x4*)(base + off + bj * HALF + 4); }
                    else { const u32x4 b4 = *(const u32x4*)(base16 + off + bj * HALF);
                        acc[ai][bj][m][0] = (f32x4){bf_lo(b4.x), bf_hi(b4.x), bf_lo(b4.y), bf_hi(b4.y)}; acc[ai][bj][m][1] = (f32x4){bf_lo(b4.z), bf_hi(b4.z), bf_lo(b4.w), bf_hi(b4.w)}; } } }
    }
    __device__ __forceinline__ void fused(f32x4 (&acc)[2][2][4][2], const Unit& u, int wr, int wc, int fr, int fq, LAS unsigned char* lds, int wid, int lane) const {
        const int col0 = u.pn * BM + wc * 32 + 8 * fq;
        st.run(acc, u, wr, wc, fr, fq, lds, wid, lane);
        const LAS float* S = (const LAS float*)(lds + 4096);
        if (WRITE_X) {
#pragma unroll
            for (int ai = 0; ai < 2; ++ai)
#pragma unroll
                for (int m = 0; m < 4; ++m) { const int r = ai * HALF + wr * 64 + m * 16 + fr; const size_t off = (size_t)(u.pm * BM + r) * 1024 + col0;
                    if (u.pn == 0 && wc == 0 && fq == 0) rs[u.pm * BM + r] = S[r];
#pragma unroll
                    for (int bj = 0; bj < 2; ++bj) { const f32x4 x0 = acc[ai][bj][m][0], x1 = acc[ai][bj][m][1];
                        u32x4 xw; xw.x = cvt_pk_bf16(x0[0], x0[1]); xw.y = cvt_pk_bf16(x0[2], x0[3]); xw.z = cvt_pk_bf16(x1[0], x1[1]); xw.w = cvt_pk_bf16(x1[2], x1[3]); *(u32x4*)(xout + off + bj * HALF) = xw; } }
        } else {
            f32x4 gv[2][2];
#pragma unroll
            for (int bj = 0; bj < 2; ++bj)
#pragma unroll
                for (int n = 0; n < 2; ++n) gv[bj][n] = *(const f32x4*)(g + col0 + bj * HALF + n * 4);
#pragma unroll
            for (int ai = 0; ai < 2; ++ai)
#pragma unroll
                for (int m = 0; m < 4; ++m) { const int r = ai * HALF + wr * 64 + m * 16 + fr; const float rstd = S[r]; const size_t off = (size_t)(u.pm * BM + r) * 1024 + col0;
#pragma unroll
                    for (int bj = 0; bj < 2; ++bj) { const f32x4 y0 = acc[ai][bj][m][0] * rstd * gv[bj][0], y1 = acc[ai][bj][m][1] * rstd * gv[bj][1];
                        *(f32x4*)(nout + off + bj * HALF) = y0; *(f32x4*)(nout + off + bj * HALF + 4) = y1; } }
        }
    }
};

template <class Epi, class Sched, class Pend>
__device__ __forceinline__ void gemm_phase(LAS unsigned char* lds, const Gemm g, const Sched& S, const Epi& E, const Pend& pend) {
    int tid = threadIdx.x; asm volatile("" : "+v"(tid));
    const int wid = __builtin_amdgcn_readfirstlane(tid >> 6), lane = tid & 63, wr = wid >> 2, wc = wid & 3, fr = lane & 15, fq = lane >> 4;
    const int K = g.K, nt = K / BK;
    unsigned voffA[2], voffB[2];
#pragma unroll
    for (int i = 0; i < 2; ++i) { int R, C; stage_rc(tid * 16 + i * 8192, R, C); const int Rb = Epi::PERM ? ((R & ~31) + perm32(R & 31)) : R;
        voffA[i] = (unsigned)(R * K + C) * 2u; voffB[i] = (unsigned)(Rb * K + C) * 2u; }
    const size_t kstep = (size_t)(BK * 2);
    const size_t hstep = (size_t)HALF * K * 2;
    const size_t tstep = 2 * hstep;
    const unsigned ldsw = (unsigned)wid * 1024u;
    const int aoff = lds_byte(wr * 64 + fr, fq * 8), boff = lds_byte(wc * 32 + fr, fq * 8);
#define PG8_SA(b, h) (((b) * 2 + (h)) * HTB)
#define PG8_SB(b, h) ((4 + (b) * 2 + (h)) * HTB)
#define PG8_STAGE(bufoff, gbase, voff) do { _Pragma("unroll") for (int _i = 0; _i < 2; ++_i) \
        __builtin_amdgcn_global_load_lds((const unsigned*)((const char*)(gbase) + (voff)[_i]), (LAS unsigned*)(lds + (bufoff) + ldsw + _i * 8192), 16, 0, 0); } while (0)
#define PG8_LDA(dst, b, h) do { _Pragma("unroll") for (int m = 0; m < 4; ++m) _Pragma("unroll") for (int k = 0; k < 2; ++k) dst[m][k] = *(const LAS bf16x8*)(lds + PG8_SA(b, h) + aoff + m * 2048 + k * 1024); } while (0)
#define PG8_LDB(dst, b, h) do { _Pragma("unroll") for (int n = 0; n < 2; ++n) _Pragma("unroll") for (int k = 0; k < 2; ++k) dst[n][k] = *(const LAS bf16x8*)(lds + PG8_SB(b, h) + boff + n * 2048 + k * 1024); } while (0)
#define PG8_MMA(ai, bj, At, Bt) do { __builtin_amdgcn_s_setprio(1); _Pragma("unroll") for (int m = 0; m < 4; ++m) _Pragma("unroll") for (int n = 0; n < 2; ++n) _Pragma("unroll") for (int k = 0; k < 2; ++k) \
        acc[ai][bj][m][n] = __builtin_amdgcn_mfma_f32_16x16x32_bf16(Bt[n][k], At[m][k], acc[ai][bj][m][n], 0, 0, 0); __builtin_amdgcn_s_setprio(0); } while (0)
#define PG8_WAIT_V(n) asm volatile("s_waitcnt vmcnt(" #n ")" ::: "memory")
#define PG8_WAIT_L(n) asm volatile("s_waitcnt lgkmcnt(" #n ")" ::: "memory")
#define PG8_BAR __builtin_amdgcn_s_barrier()
#define PG8_SCHED __builtin_amdgcn_sched_barrier(0)
    Unit cur, nxt; int ui = 0;
    if (!S.next(0, cur)) return;
    f32x4 acc[2][2][4][2];
    if constexpr (Epi::HAS_INIT) E.init(acc, cur, wr, wc, fr, fq);
    else {
#pragma unroll
        for (int a = 0; a < 2; ++a)
#pragma unroll
            for (int b = 0; b < 2; ++b)
#pragma unroll
                for (int m = 0; m < 4; ++m)
#pragma unroll
                    for (int n = 0; n < 2; ++n) acc[a][b][m][n] = (f32x4){0.f, 0.f, 0.f, 0.f};
    }
    pend.early();
    bf16x8 At[4][2], B0[2][2], B1[2][2];
    const char* cA = (const char*)g.A + (size_t)cur.pm * tstep; const char* cB = (const char*)g.Bt + (size_t)cur.pn * tstep;
    PG8_STAGE(PG8_SB(0, 0), cB, voffB); PG8_STAGE(PG8_SB(0, 1), cB + hstep, voffB); PG8_STAGE(PG8_SA(0, 0), cA, voffA); PG8_STAGE(PG8_SA(0, 1), cA + hstep, voffA);
    if (wr == 1) PG8_BAR;
    PG8_WAIT_V(2); PG8_BAR;
    PG8_STAGE(PG8_SB(1, 0), cB + kstep, voffB); PG8_STAGE(PG8_SA(1, 0), cA + kstep, voffA); PG8_STAGE(PG8_SB(1, 1), cB + hstep + kstep, voffB);
    PG8_WAIT_V(6); PG8_BAR;
    for (;;) {
        const bool has_next = S.next(ui + 1, nxt);
        const char* nA = has_next ? (const char*)g.A + (size_t)nxt.pm * tstep : cA; const char* nB = has_next ? (const char*)g.Bt + (size_t)nxt.pn * tstep : cB;
        for (int t = 0; t < nt; t += 2) {
            const bool last = (t == nt - 2);
            const char* a1 = cA + (size_t)(t + 1) * kstep;
            const char* a2 = last ? nA : cA + (size_t)(t + 2) * kstep; const char* b2 = last ? nB : cB + (size_t)(t + 2) * kstep;
            const char* a3 = a2 + kstep; const char* b3 = b2 + kstep;
            PG8_LDB(B0, 0, 0); PG8_LDB(B1, 0, 1); PG8_SCHED; PG8_LDA(At, 0, 0); PG8_STAGE(PG8_SA(1, 1), a1 + hstep, voffA);
            PG8_WAIT_V(8); PG8_WAIT_L(0); PG8_BAR; PG8_MMA(0, 0, At, B0); PG8_MMA(0, 1, At, B1); PG8_BAR; PG8_SCHED;
            PG8_LDA(At, 0, 1); PG8_STAGE(PG8_SB(0, 0), b2, voffB); PG8_STAGE(PG8_SB(0, 1), b2 + hstep, voffB); PG8_STAGE(PG8_SA(0, 0), a2, voffA);
            PG8_WAIT_V(8); PG8_WAIT_L(0); PG8_BAR; PG8_MMA(1, 0, At, B0); PG8_MMA(1, 1, At, B1); PG8_BAR; PG8_SCHED;
            PG8_LDB(B0, 1, 0); PG8_LDB(B1, 1, 1); PG8_SCHED; PG8_LDA(At, 1, 0); PG8_STAGE(PG8_SA(0, 1), a2 + hstep, voffA);
            PG8_WAIT_V(8); PG8_WAIT_L(0); PG8_BAR; PG8_MMA(0, 0, At, B0); PG8_MMA(0, 1, At, B1); PG8_BAR; PG8_SCHED;
            PG8_LDA(At, 1, 1); PG8_STAGE(PG8_SB(1, 0), b3, voffB); PG8_STAGE(PG8_SB(1, 1), b3 + hstep, voffB); PG8_STAGE(PG8_SA(1, 0), a3, voffA);
            PG8_WAIT_V(8); PG8_WAIT_L(0); PG8_BAR; PG8_MMA(1, 0, At, B0); PG8_MMA(1, 1, At, B1); PG8_BAR; PG8_SCHED;
        }
        if (wr == 0) PG8_BAR;
        if (ui == 0) pend.wait();
        if constexpr (!Epi::AFTER_DRAIN) E(acc, cur, wr, wc, fr, fq);
        if (!has_next) break;
#pragma unroll
        for (int a = 0; a < 2; ++a)
#pragma unroll
            for (int b = 0; b < 2; ++b)
#pragma unroll
                for (int m = 0; m < 4; ++m)
#pragma unroll
                    for (int n = 0; n < 2; ++n) acc[a][b][m][n] = (f32x4){0.f, 0.f, 0.f, 0.f};
        cur = nxt; cA = nA; cB = nB; ++ui;
        if (wr == 1) PG8_BAR;
    }
    PG8_WAIT_V(0);
    PG8_BAR;
    if constexpr (Epi::AFTER_DRAIN) E.fused(acc, cur, wr, wc, fr, fq, lds, wid, lane);
#undef PG8_SA
#undef PG8_SB
#undef PG8_STAGE
#undef PG8_LDA
#undef PG8_LDB
#undef PG8_MMA
#undef PG8_WAIT_V
#undef PG8_WAIT_L
#undef PG8_BAR
#undef PG8_SCHED
}
}


#define XB_TMO      128
#define XB_XCNT(j)  (256  + 64 * (j))
#define XB_XSUB(j)  (1280 + 64 * (j))
#define XB_XGEN(j)  (2304 + 64 * (j))
#define XB_TOP      3328
#define XB_TOPGEN   3392
#define XCD_BAR_WORDS 3456
#define XB_SPIN_CAP (1u << 22)
__device__ __forceinline__ unsigned xb_ld(unsigned* p)              { return __hip_atomic_load(p, __ATOMIC_RELAXED, __HIP_MEMORY_SCOPE_AGENT); }
__device__ __forceinline__ unsigned xb_add(unsigned* p, unsigned v) { return __hip_atomic_fetch_add(p, v, __ATOMIC_RELAXED, __HIP_MEMORY_SCOPE_AGENT); }
__device__ __forceinline__ unsigned xb_xcc_id() { return (unsigned)__builtin_amdgcn_s_getreg((3 << 11) | 20) & 0xFu; }
#define XB_SPIN(cond, bar) do { unsigned _sp = 0; while (cond) { __builtin_amdgcn_s_sleep(1); \
    if ((++_sp & 255u) == 0u) { if (xb_ld(&(bar)[XB_TMO])) break; if (_sp > XB_SPIN_CAP) { atomicAdd(&(bar)[XB_TMO], 1u); break; } } } } while (0)
struct XcdBarrier { unsigned* bar; unsigned x; volatile LAS unsigned* st; };
__device__ __forceinline__ XcdBarrier xcd_barrier_post(unsigned* bar, volatile LAS unsigned* st) {
    XcdBarrier b; b.bar = bar; b.x = xb_xcc_id(); b.st = st;
    if (threadIdx.x == 0) (void)xb_add(&bar[XB_XCNT(b.x)], 1u);
    return b;
}
__device__ __forceinline__ void xcd_barrier_complete(unsigned* bar, unsigned x, unsigned& nloc, unsigned& nx) {
    const unsigned G = gridDim.x * gridDim.y * gridDim.z;
    unsigned sum, cnt, mine, sp = 0u;
    for (;;) {
        sum = 0u; cnt = 0u; mine = 0u;
#pragma unroll
        for (unsigned j = 0; j < 16; ++j) { const unsigned c = xb_ld(&bar[XB_XCNT(j)]); sum += c; cnt += (c > 0u) ? 1u : 0u; mine = (j == x) ? c : mine; }
        if (sum == G) break;
        __builtin_amdgcn_s_sleep(1);
        if ((++sp & 255u) == 0u) { if (xb_ld(&bar[XB_TMO])) break; if (sp > XB_SPIN_CAP) { atomicAdd(&bar[XB_TMO], 1u); break; } }
    }
    nloc = mine > 0u ? mine : 1u; nx = cnt > 0u ? cnt : 1u;
}
__device__ __forceinline__ void xcd_arrive(const XcdBarrier& b) {
    asm volatile("s_waitcnt vmcnt(0)" ::: "memory");
    __syncthreads();
    if (threadIdx.x == 0) {
        unsigned* bar = b.bar;
        __builtin_amdgcn_s_waitcnt(0);
        unsigned nloc = b.st[0], nx = b.st[1];
        if (nloc == 0u) { xcd_barrier_complete(bar, b.x, nloc, nx); b.st[0] = nloc; b.st[1] = nx; }
        const unsigned old = xb_add(&bar[XB_XSUB(b.x)], 1u);
        const unsigned gen = old / nloc;
        if (old + 1u == (gen + 1u) * nloc) {
            __builtin_amdgcn_fence(__ATOMIC_RELEASE, "agent");
            asm volatile("s_waitcnt vmcnt(0)" ::: "memory");
            (void)xb_add(&bar[XB_TOP], 1u);
        }
        b.st[2] = (gen + 1u) * nx;
    }
}
__device__ __forceinline__ void xcd_wait(const XcdBarrier& b) {
    if (threadIdx.x == 0) {
        unsigned* bar = b.bar; const unsigned want = b.st[2];
        XB_SPIN(xb_ld(&bar[XB_TOP]) < want, bar);
        __builtin_amdgcn_fence(__ATOMIC_ACQUIRE, "agent");
        asm volatile("s_waitcnt vmcnt(0)" ::: "memory");
    }
    __syncthreads();
}
__device__ __forceinline__ void xcd_barrier(const XcdBarrier& b) { xcd_arrive(b); xcd_wait(b); }
struct NoPend    { __device__ __forceinline__ void early() const {} __device__ __forceinline__ void wait() const {} };
struct BarPend   { const XcdBarrier* b; __device__ __forceinline__ void early() const {} __device__ __forceinline__ void wait() const { xcd_wait(*b); } };
struct EarlyPend { const XcdBarrier* b; __device__ __forceinline__ void early() const { xcd_wait(*b); } __device__ __forceinline__ void wait() const {} };
constexpr size_t WS_RS = WS_LSE + 512 * 1024 + 65536;
constexpr size_t WS_BAR = WS_LSE + 512 * 1024, WS_CNT0 = WS_BAR + 16384, WS_CNT1 = WS_BAR + 32768, WS_XB0 = WS_LSE + 768 * 1024, WS_XB1 = WS_WSB + 256 * 1024;
constexpr int MISC_OFF = LDS_BYTES - 128;

struct Args {
    const float* x; const float* even_norm; const float* even_w_in; const float* even_pool_w; const float* even_pool_scale; const float* even_ws; const float* even_bs;
    const float* even_w_out; const float* odd_norm; const float* odd_w_in; const float* odd_conv_w; const float* odd_w_out; const float* final_norm;
    float* out; unsigned char* ws; int ph_lo, ph_hi;
};

struct TItem { const float* W; bf16_t* WT; int N, K, k0, nsrc0, ndst0; const float* ks; };
__device__ __forceinline__ void titem_load(const TItem& t, f32x4 (&v)[8], int lane) {
#pragma unroll
    for (int i = 0; i < 8; ++i) v[i] = *(const f32x4*)(t.W + (size_t)(t.k0 + 8 * i + (lane >> 3)) * t.N + t.nsrc0 + 4 * (lane & 7));
}
__device__ __forceinline__ void titem_finish(const TItem& t, const f32x4 (&v)[8], LAS float* scr, int lane) {
#pragma unroll
    for (int i = 0; i < 8; ++i) { LAS float* d = scr + (8 * i + (lane >> 3)) * 33 + 4 * (lane & 7); d[0] = v[i][0]; d[1] = v[i][1]; d[2] = v[i][2]; d[3] = v[i][3]; }
    asm volatile("s_waitcnt lgkmcnt(0)" ::: "memory");
    const int c = lane & 7;
    f32x4 k0v = {1.f, 1.f, 1.f, 1.f}, k1v = {1.f, 1.f, 1.f, 1.f};
    if (t.ks) { k0v = *(const f32x4*)(t.ks + t.k0 + 8 * c); k1v = *(const f32x4*)(t.ks + t.k0 + 8 * c + 4); }
#pragma unroll
    for (int j = 0; j < 4; ++j) { const int n = (lane >> 3) + 8 * j; const LAS float* sp = scr + (8 * c) * 33 + n;
        u32x4 o; o.x = cvt_pk_bf16(sp[0 * 33] * k0v[0], sp[1 * 33] * k0v[1]); o.y = cvt_pk_bf16(sp[2 * 33] * k0v[2], sp[3 * 33] * k0v[3]); o.z = cvt_pk_bf16(sp[4 * 33] * k1v[0], sp[5 * 33] * k1v[1]); o.w = cvt_pk_bf16(sp[6 * 33] * k1v[2], sp[7 * 33] * k1v[3]);
        *(u32x4*)(t.WT + (size_t)(t.ndst0 + n) * t.K + t.k0 + 8 * c) = o; }
    asm volatile("s_waitcnt lgkmcnt(0)" ::: "memory");
}
__device__ __forceinline__ int w1_dst_row(int n) {
    if (n < 2048) return n;
    if (n < 3072) { const int ch = n - 2048; return 3072 + (ch / 128) * 256 + ch % 128; }
    if (n < 4096) return n - 1024;
    { const int ch = n - 4096; return 3072 + (ch / 128) * 256 + 128 + ch % 128; }
}
__device__ __forceinline__ int w3_dst_row(int n) {
    if (n < 9216) { const int which = n / 3072, rem = n % 3072, gi = rem / 1024, j = rem % 1024; return gi * 3072 + which * 1024 + j; }
    if (n < 10240) return n + 2048;
    const int rel = n - 10240, type = rel / 1024, ch = rel % 1024, t128 = ch / 128, within = ch % 128;
    if (type == 1 || type == 2) return 9216 + t128 * 256 + (type == 1 ? 0 : 128) + within;
    return 12288 + t128 * 256 + (type == 0 ? 0 : 128) + within;
}
__device__ __forceinline__ TItem w3_item(const float* W, bf16_t* W3T, const float* ks, int col0, int nb, int idx) { const int kb = idx / nb, nbk = idx % nb, src = col0 + nbk * 32; return TItem{W, W3T, ODD_IN, DM, kb * 64, src, w3_dst_row(src), ks}; }
__device__ __forceinline__ TItem wo_item(const float* W, bf16_t* WT, int idx) { const int kb = idx / 32, nbk = idx % 32; return TItem{W, WT, DM, DI, kb * 64, nbk * 32, nbk * 32, nullptr}; }
__device__ __forceinline__ TItem qkv_item(const float* W, bf16_t* W3T, const float* ks, int gi, int r) { const int which = r / 512; return w3_item(W, W3T, ks, which * 3072 + gi * 1024, 32, r % 512); }
template <int SEAM>
__device__ __forceinline__ void seam_convert(const float* w_out_even, const float* w_in_odd, const float* g_odd, const float* w_out_odd, bf16_t* W2T, bf16_t* W3T, bf16_t* W4T, LAS float* scr, int gw, int NGW, int lane) {
    constexpr int total = (SEAM == 1) ? 2048 : (SEAM == 2) ? 1536 : (SEAM == 3) ? 2048 : (SEAM == 4) ? 2048 : 1536;
    for (int i = gw; i < total; i += NGW) {
        TItem T;
        if (SEAM == 1) { if (i < 1024) T = wo_item(w_out_even, W2T, i); else T = qkv_item(w_in_odd, W3T, g_odd, 0, i - 1024); }
        else if (SEAM == 2) { if (i < 512) T = qkv_item(w_in_odd, W3T, g_odd, 0, 1024 + i); else T = wo_item(w_out_odd, W4T, i - 512); }
        else if (SEAM == 3) { if (i < 1536) T = qkv_item(w_in_odd, W3T, g_odd, 1, i); else T = w3_item(w_in_odd, W3T, g_odd, 11264, 64, i - 1536); }
        else if (SEAM == 4) { if (i < 1536) T = qkv_item(w_in_odd, W3T, g_odd, 2, i); else T = w3_item(w_in_odd, W3T, g_odd, 11264, 64, 512 + (i - 1536)); }
        else { if (i < 512) T = w3_item(w_in_odd, W3T, g_odd, 9216, 32, i); else if (i < 1024) T = w3_item(w_in_odd, W3T, g_odd, 10240, 32, i - 512); else T = w3_item(w_in_odd, W3T, g_odd, 13312, 32, i - 1024); }
        f32x4 v[8]; titem_load(T, v, lane); titem_finish(T, v, scr, lane);
    }
}
__device__ __forceinline__ void rms_row_bf16(const float* xrow, const float* g, bf16_t* orow, int lane) {
    const f32x4* xr = (const f32x4*)xrow + lane; const f32x4* gr = (const f32x4*)g + lane;
    f32x4 v[4]; float s = 0.f;
#pragma unroll
    for (int j = 0; j < 4; ++j) { v[j] = xr[64 * j]; s += (v[j].x * v[j].x + v[j].y * v[j].y) + (v[j].z * v[j].z + v[j].w * v[j].w); }
    const float rstd = rsqrtf(wave_sum(s) * (1.f / DM) + EPS);
    u32x2* o8 = (u32x2*)orow + lane;
#pragma unroll
    for (int j = 0; j < 4; ++j) { const f32x4 gg = gr[64 * j]; u32x2 w; w.x = cvt_pk_bf16(v[j].x * rstd * gg.x, v[j].y * rstd * gg.y); w.y = cvt_pk_bf16(v[j].z * rstd * gg.z, v[j].w * rstd * gg.w); o8[64 * j] = w; }
}
__device__ __forceinline__ void rms_row2_bf16(const float* xa, const float* xb, const float* g, bf16_t* oa, bf16_t* ob, int lane) {
    const f32x4* pa = (const f32x4*)xa + lane; const f32x4* pb = (const f32x4*)xb + lane; const f32x4* gr = (const f32x4*)g + lane;
    f32x4 va[4], vb[4]; float sa = 0.f, sb = 0.f;
#pragma unroll
    for (int j = 0; j < 4; ++j) { va[j] = pa[64 * j]; vb[j] = pb[64 * j]; }
#pragma unroll
    for (int j = 0; j < 4; ++j) { sa += (va[j].x * va[j].x + va[j].y * va[j].y) + (va[j].z * va[j].z + va[j].w * va[j].w); sb += (vb[j].x * vb[j].x + vb[j].y * vb[j].y) + (vb[j].z * vb[j].z + vb[j].w * vb[j].w); }
    const float ra = rsqrtf(wave_sum(sa) * (1.f / DM) + EPS), rb = rsqrtf(wave_sum(sb) * (1.f / DM) + EPS);
    u32x2* qa = (u32x2*)oa + lane; u32x2* qb = (u32x2*)ob + lane;
#pragma unroll
    for (int j = 0; j < 4; ++j) { const f32x4 gg = gr[64 * j]; u32x2 w;
        w.x = cvt_pk_bf16(va[j].x * ra * gg.x, va[j].y * ra * gg.y); w.y = cvt_pk_bf16(va[j].z * ra * gg.z, va[j].w * ra * gg.w); qa[64 * j] = w;
        w.x = cvt_pk_bf16(vb[j].x * rb * gg.x, vb[j].y * rb * gg.y); w.y = cvt_pk_bf16(vb[j].z * rb * gg.z, vb[j].w * rb * gg.w); qb[64 * j] = w; }
}
__device__ __forceinline__ void fold_item(const float* Win, const float* PW, bf16_t* W1T, LAS float* sm, int item, int tid) {
    LAS float* As = sm;
    LAS float* Bs = sm + 64 * 33;
    const int k0 = (item >> 4) * 64, n0 = (item & 15) * 64, g = n0 >> 8, d0 = n0 & 255;
    const int tk = tid >> 4, tn = tid & 15;
    float acc[2][4];
#pragma unroll
    for (int i = 0; i < 2; ++i)
#pragma unroll
        for (int j = 0; j < 4; ++j) acc[i][j] = 0.f;
    float ra[4], rb[4];
#pragma unroll
    for (int i = 0; i < 4; ++i) { const int idx = tid + 512 * i; ra[i] = Win[(size_t)(k0 + (idx >> 5)) * EVEN_IN + g * 256 + (idx & 31)]; rb[i] = PW[((size_t)(g * 256 + (idx >> 6))) * 256 + d0 + (idx & 63)]; }
    for (int c0 = 0; c0 < 256; c0 += 32) {
        __syncthreads();
#pragma unroll
        for (int i = 0; i < 4; ++i) { const int idx = tid + 512 * i; As[(idx >> 5) * 33 + (idx & 31)] = ra[i]; Bs[(idx >> 6) * 64 + (idx & 63)] = rb[i]; }
        __syncthreads();
        if (c0 + 32 < 256) {
#pragma unroll
            for (int i = 0; i < 4; ++i) { const int idx = tid + 512 * i; ra[i] = Win[(size_t)(k0 + (idx >> 5)) * EVEN_IN + g * 256 + c0 + 32 + (idx & 31)]; rb[i] = PW[((size_t)(g * 256 + c0 + 32 + (idx >> 6))) * 256 + d0 + (idx & 63)]; }
        }
#pragma unroll 8
        for (int c = 0; c < 32; ++c) { const float a0 = As[(2 * tk) * 33 + c], a1 = As[(2 * tk + 1) * 33 + c]; const f32x4 b = *(const LAS f32x4*)(Bs + c * 64 + 4 * tn);
#pragma unroll
            for (int j = 0; j < 4; ++j) { acc[0][j] += a0 * b[j]; acc[1][j] += a1 * b[j]; } }
    }
#pragma unroll
    for (int j = 0; j < 4; ++j) *(unsigned*)(W1T + (size_t)(n0 + 4 * tn + j) * DM + k0 + 2 * tk) = cvt_pk_bf16(acc[0][j], acc[1][j]);
}

__device__ __forceinline__ void unpack8(const u32x4 v, float (&f)[8]) { f[0] = bf_lo(v.x); f[1] = bf_hi(v.x); f[2] = bf_lo(v.y); f[3] = bf_hi(v.y); f[4] = bf_lo(v.z); f[5] = bf_hi(v.z); f[6] = bf_lo(v.w); f[7] = bf_hi(v.w); }
template <int W>
__device__ __forceinline__ void ya_run(const bf16_t* Z1, const float* scale, bf16_t* Y1, int t0, int oc) {
    const int tl0 = t0 & (SEQ - 1);
    constexpr int RUN = 8;
    u32x4 R[W + RUN - 1];
#pragma unroll
    for (int k = 0; k < W + RUN - 1; ++k) { const int dt = k - (W - 1); R[k] = (tl0 + dt >= 0) ? *(const u32x4*)(Z1 + (size_t)(t0 + dt) * ZP + oc * 8) : (u32x4){0u, 0u, 0u, 0u}; }
    const f32x4 sc0 = *(const f32x4*)(scale + oc * 8), sc1 = *(const f32x4*)(scale + oc * 8 + 4);
    const float sc[8] = {sc0[0], sc0[1], sc0[2], sc0[3], sc1[0], sc1[1], sc1[2], sc1[3]};
    float s[8];
#pragma unroll
    for (int e = 0; e < 8; ++e) s[e] = 0.f;
#pragma unroll
    for (int k = 0; k < W - 1; ++k) { float f[8]; unpack8(R[k], f);
#pragma unroll
        for (int e = 0; e < 8; ++e) s[e] += f[e]; }
    u32x4 GA[RUN];
#pragma unroll
    for (int i = 0; i < RUN; ++i) GA[i] = *(const u32x4*)(Z1 + (size_t)(t0 + i) * ZP + 1024 + oc * 8);
#pragma unroll
    for (int i = 0; i < RUN; ++i) {
        float cur[8]; unpack8(R[i + W - 1], cur);
#pragma unroll
        for (int e = 0; e < 8; ++e) s[e] += cur[e];
        if (i > 0) { u32x4 tmp = R[i - 1]; asm volatile("" : "+v"(tmp)); float old[8]; unpack8(tmp, old);
#pragma unroll
            for (int e = 0; e < 8; ++e) s[e] -= old[e]; }
        const int tl = tl0 + i; const float inv = 1.0f / (float)((tl + 1 < W) ? tl + 1 : W);
        float gg[8]; unpack8(GA[i], gg);
        float o[8];
#pragma unroll
        for (int e = 0; e < 8; ++e) o[e] = (s[e] * inv - cur[e]) * sc[e] * gg[e];
        u32x4 w4; w4.x = cvt_pk_bf16(o[0], o[1]); w4.y = cvt_pk_bf16(o[2], o[3]); w4.z = cvt_pk_bf16(o[4], o[5]); w4.w = cvt_pk_bf16(o[6], o[7]);
        *(u32x4*)(Y1 + (size_t)(t0 + i) * DI + oc * 8) = w4;
    }
}
__device__ __forceinline__ void ya_phase(const bf16_t* Z1, const float* scale, bf16_t* Y1, int gw, int NGW, int lane) {
    for (int it = gw; it < 4 * 1024; it += NGW) {
        const int g = it & 3, rp = it >> 2;
        const int t0 = (rp * 2 + (lane >> 5)) * 8, oc = g * 32 + (lane & 31);
        if (g == 0) ya_run<2>(Z1, scale, Y1, t0, oc); else if (g == 1) ya_run<4>(Z1, scale, Y1, t0, oc); else if (g == 2) ya_run<8>(Z1, scale, Y1, t0, oc); else ya_run<16>(Z1, scale, Y1, t0, oc);
    }
}
constexpr int VB_STRIDE = 544;
__device__ __forceinline__ void yb_phase(LAS unsigned char* lds, const bf16_t* Z1, const bf16_t* WSB, const float* bs, bf16_t* Y1, int G, int bid) {
    int tid = threadIdx.x; asm volatile("" : "+v"(tid));
    const int lane = tid & 63, w = __builtin_amdgcn_readfirstlane(tid >> 6), ql = lane & 15, gq = lane >> 4;
    for (int unit = bid; unit < 512; unit += G) {
        const int ck = unit >> 2, g = unit & 3, row0 = ck * 128;
        __syncthreads();
#pragma unroll
        for (int i = 0; i < 8; ++i) { const int idx = tid + 512 * i, rr = idx >> 5, ch = idx & 31;
            const u32x4 val = *(const u32x4*)(Z1 + (size_t)(row0 + rr) * ZP + 2048 + 256 * g + ch * 8);
            *(LAS u32x4*)(lds + rr * VB_STRIDE + ch * 16) = val; }
        __syncthreads();
        const int t = 16 * w + ql;
        bf16x8 wf[4];
#pragma unroll
        for (int ks = 0; ks < 4; ++ks) wf[ks] = *(const bf16x8*)(WSB + (size_t)(g * 128 + t) * 128 + 32 * ks + 8 * gq);
        const int nks = (w >> 1) + 1;
        const size_t rowg = (size_t)(row0 + t);
        const float bias = bs[g * 128 + t];
        const LAS unsigned char* vbase = lds + (8 * gq + (ql >> 2)) * VB_STRIDE + (ql & 3) * 8;
        u32x2 ua[16];
#pragma unroll
        for (int cb = 0; cb < 16; ++cb) { const int c0 = 256 * g + 16 * cb + 4 * gq; ua[cb] = *(const u32x2*)(Z1 + rowg * ZP + 3072 + c0); }
#pragma unroll
        for (int cb = 0; cb < 16; ++cb) {
            f32x4 acc = {0.f, 0.f, 0.f, 0.f};
#pragma unroll
            for (int ks = 0; ks < 4; ++ks) {
                if (ks < nks) {
                    const LAS unsigned char* p = vbase + ks * 32 * VB_STRIDE + cb * 32;
                    const s16x4 lo = tr_read(p), hi = tr_read(p + 4 * VB_STRIDE);
                    acc = __builtin_amdgcn_mfma_f32_16x16x32_bf16(cat8(lo, hi), wf[ks], acc, 0, 0, 0);
                }
            }
            const int c0 = 256 * g + 16 * cb + 4 * gq;
            const u32x2 u2 = ua[cb];
            const float o0 = bf_lo(u2.x) * (acc[0] + bias), o1 = bf_hi(u2.x) * (acc[1] + bias);
            const float o2 = bf_lo(u2.y) * (acc[2] + bias), o3 = bf_hi(u2.y) * (acc[3] + bias);
            u32x2 o; o.x = cvt_pk_bf16(o0, o1); o.y = cvt_pk_bf16(o2, o3);
            *(u32x2*)(Y1 + rowg * DI + 1024 + c0) = o;
        }
    }
}

constexpr int KV_STRIDE = 272, KV_BLK = 128 * KV_STRIDE, V_STRIDE = 288, V_BLK = 128 * V_STRIDE, V_BASE = 2 * KV_BLK;
template <int gi>
__device__ __forceinline__ void attn_group_phase(LAS unsigned char* lds, const bf16_t* QKV, bf16_t* O, float* LSE, int G, int bid) {
    int tid = threadIdx.x; asm volatile("" : "+v"(tid));
    const int lane = tid & 63, w = __builtin_amdgcn_readfirstlane(tid >> 6), ql = lane & 15, gq = lane >> 4;
    constexpr int dil = (gi == 0) ? 1 : (gi == 1) ? 4 : 16, nb = 64 / dil, rps = nb / 4;
    for (int job = bid; job < 256; job += G) {
        const int sub = job / rps, n0 = (job % rps) * 4;
        const int r = sub % dil, h = (sub / dil) & 7, b = sub / (dil * 8);
        const float slope = exp2f(-8.0f * (float)(gi * 8 + h + 1) / 24.0f);
        const float c1 = 0.08838834764831845f * 1.4426950408889634f, c2 = slope * (float)dil * 1.4426950408889634f;
        const size_t rowb = (size_t)b * SEQ;
        const int lrow = tid >> 4, lch = tid & 15;
        __syncthreads();
        {
            const int sp = (n0 - 1) & 1;
            LAS unsigned char* kd = lds + sp * KV_BLK; LAS unsigned char* vd = lds + V_BASE + sp * V_BLK;
            if (n0 == 0) {
#pragma unroll
                for (int ps = 0; ps < 4; ++ps) { const int rr = lrow + 32 * ps; *(LAS u32x4*)(kd + rr * KV_STRIDE + lch * 16) = (u32x4){0u, 0u, 0u, 0u}; *(LAS u32x4*)(vd + rr * V_STRIDE + lch * 16) = (u32x4){0u, 0u, 0u, 0u}; }
            } else {
                u32x4 tk[4], tv[4];
#pragma unroll
                for (int ps = 0; ps < 4; ++ps) { const int rr = lrow + 32 * ps; const size_t grow = rowb + (size_t)(128 * (n0 - 1) + rr) * dil + r;
                    const bf16_t* src = QKV + grow * 3072 + h * 128 + lch * 8; tk[ps] = *(const u32x4*)(src + 1024); tv[ps] = *(const u32x4*)(src + 2048); }
#pragma unroll
                for (int ps = 0; ps < 4; ++ps) { const int rr = lrow + 32 * ps; *(LAS u32x4*)(kd + rr * KV_STRIDE + lch * 16) = tk[ps]; *(LAS u32x4*)(vd + rr * V_STRIDE + lch * 16) = tv[ps]; }
            }
        }
        u32x4 pk[4], pv[4];
#pragma unroll
        for (int ps = 0; ps < 4; ++ps) { const int rr = lrow + 32 * ps; const size_t grow = rowb + (size_t)(128 * n0 + rr) * dil + r;
            const bf16_t* src = QKV + grow * 3072 + h * 128 + lch * 8; pk[ps] = *(const u32x4*)(src + 1024); pv[ps] = *(const u32x4*)(src + 2048); }
        for (int n = n0; n < n0 + 4; ++n) {
            const size_t growq = rowb + (size_t)(128 * n + 16 * w + ql) * dil + r;
            bf16x8 qf[4];
#pragma unroll
            for (int ks = 0; ks < 4; ++ks) qf[ks] = *(const bf16x8*)(QKV + growq * 3072 + h * 128 + 32 * ks + 8 * gq);
            {
                const int sc = n & 1;
                LAS unsigned char* kd = lds + sc * KV_BLK; LAS unsigned char* vd = lds + V_BASE + sc * V_BLK;
#pragma unroll
                for (int ps = 0; ps < 4; ++ps) { const int rr = lrow + 32 * ps; *(LAS u32x4*)(kd + rr * KV_STRIDE + lch * 16) = pk[ps]; *(LAS u32x4*)(vd + rr * V_STRIDE + lch * 16) = pv[ps]; }
            }
            __syncthreads();
            float* lsep = LSE + growq * 8 + h;
            bf16_t* op = O + growq * 1024 + h * 128 + 4 * gq;
            float lse_prev = 0.f; u32x2 oprev[8];
            if (gi > 0) { lse_prev = *lsep;
#pragma unroll
                for (int db = 0; db < 8; ++db) oprev[db] = *(const u32x2*)(op + 16 * db); }
            if (n + 1 < n0 + 4) {
#pragma unroll
                for (int ps = 0; ps < 4; ++ps) { const int rr = lrow + 32 * ps; const size_t grow = rowb + (size_t)(128 * (n + 1) + rr) * dil + r;
                    const bf16_t* src = QKV + grow * 3072 + h * 128 + lch * 8; pk[ps] = *(const u32x4*)(src + 1024); pv[ps] = *(const u32x4*)(src + 2048); }
            }
            f32x4 S[9];
#pragma unroll
            for (int kb = 0; kb < 9; ++kb) {
                const int kabs = w + kb, slot = (kabs < 8) ? ((n - 1) & 1) : (n & 1);
                const LAS unsigned char* kp = lds + slot * KV_BLK + ((kabs & 7) * 16 + ql) * KV_STRIDE + gq * 16;
                f32x4 acc = {0.f, 0.f, 0.f, 0.f};
#pragma unroll
                for (int ks = 0; ks < 4; ++ks) acc = __builtin_amdgcn_mfma_f32_16x16x32_bf16(*(const LAS bf16x8*)(kp + 64 * ks), qf[ks], acc, 0, 0, 0);
                S[kb] = acc;
            }
            float mx = -1e30f;
#pragma unroll
            for (int kb = 0; kb < 9; ++kb) {
                const bool blk_ok = (n > 0) || (w + kb >= 8);
#pragma unroll
                for (int e = 0; e < 4; ++e) {
                    const int steps = 128 + ql - 16 * kb - 4 * gq - e;
                    const bool ok = blk_ok && steps >= 0 && steps <= 128;
                    const float v = ok ? S[kb][e] * c1 - c2 * (float)steps : -1e30f;
                    S[kb][e] = v; mx = fmaxf(mx, v);
                }
            }
            mx = fmaxf(mx, __shfl_xor(mx, 16)); mx = fmaxf(mx, __shfl_xor(mx, 32));
            float l = 0.f;
#pragma unroll
            for (int kb = 0; kb < 9; ++kb)
#pragma unroll
                for (int e = 0; e < 4; ++e) { const float p = __builtin_amdgcn_exp2f(S[kb][e] - mx); S[kb][e] = p; l += p; }
            l += __shfl_xor(l, 16); l += __shfl_xor(l, 32);
            f32x4 o[8];
#pragma unroll
            for (int db = 0; db < 8; ++db) o[db] = (f32x4){0.f, 0.f, 0.f, 0.f};
#pragma unroll
            for (int p = 0; p < 5; ++p) {
                const int kx = w + 2 * p, ky = (p < 4) ? kx + 1 : kx;
                const f32x4 X = S[2 * p]; const f32x4 Yv = (p < 4) ? S[(p < 4) ? 2 * p + 1 : 0] : (f32x4){0.f, 0.f, 0.f, 0.f};
                u32x4 pw; pw.x = cvt_pk_bf16(X[0], X[1]); pw.y = cvt_pk_bf16(X[2], X[3]); pw.z = cvt_pk_bf16(Yv[0], Yv[1]); pw.w = cvt_pk_bf16(Yv[2], Yv[3]);
                const bf16x8 pf = __builtin_bit_cast(bf16x8, pw);
                const int sx = (kx < 8) ? ((n - 1) & 1) : (n & 1), sy = (ky < 8) ? ((n - 1) & 1) : (n & 1);
                const LAS unsigned char* vx = lds + V_BASE + sx * V_BLK + ((kx & 7) * 16 + 4 * gq + (ql >> 2)) * V_STRIDE + (ql & 3) * 8;
                const LAS unsigned char* vy = lds + V_BASE + sy * V_BLK + ((ky & 7) * 16 + 4 * gq + (ql >> 2)) * V_STRIDE + (ql & 3) * 8;
#pragma unroll
                for (int db = 0; db < 8; ++db) { const s16x4 lo = tr_read(vx + db * 32), hi = tr_read(vy + db * 32);
                    o[db] = __builtin_amdgcn_mfma_f32_16x16x32_bf16(cat8(lo, hi), pf, o[db], 0, 0, 0); }
            }
            const float inv_l = 1.0f / l;
            const float lse_cur = (mx + __builtin_amdgcn_logf(l)) * 0.6931471805599453f;
            float ca = 0.f, cb = inv_l, lse_new = lse_cur;
            if (gi > 0) {
                const float mm = fmaxf(lse_prev, lse_cur);
                const float wp = __expf(lse_prev - mm), wcur = __expf(lse_cur - mm), inv = 1.0f / (wp + wcur);
                ca = wp * inv; cb = wcur * inv * inv_l; lse_new = mm + __logf(wp + wcur);
            }
#pragma unroll
            for (int db = 0; db < 8; ++db) {
                f32x4 v = o[db] * cb;
                if (gi > 0) { const u32x2 pr = oprev[db]; v[0] += ca * bf_lo(pr.x); v[1] += ca * bf_hi(pr.x); v[2] += ca * bf_lo(pr.y); v[3] += ca * bf_hi(pr.y); }
                u32x2 st; st.x = cvt_pk_bf16(v[0], v[1]); st.y = cvt_pk_bf16(v[2], v[3]);
                *(u32x2*)(op + 16 * db) = st;
            }
            if (gq == 0) *lsep = lse_new;
            __syncthreads();
        }
    }
}


template <int gi>
__device__ __forceinline__ void attn_naive_phase(const bf16_t* QKV, bf16_t* O, float* LSE, int gw, int NGW, int lane) {
    constexpr int dil = (gi == 0) ? 1 : (gi == 1) ? 4 : 16;
    for (int it = gw; it < M_TOK * 8; it += NGW) {
        const int row = it >> 3, h = it & 7, tl = row & (SEQ - 1);
        const float slope = exp2f(-8.0f * (float)(gi * 8 + h + 1) / 24.0f) * (float)dil;
        const unsigned qq = *(const unsigned*)(QKV + (size_t)row * 3072 + h * 128 + 2 * lane);
        const float q0 = bf_lo(qq), q1 = bf_hi(qq);
        float m = -1e30f, l = 0.f, o0 = 0.f, o1 = 0.f;
        for (int j = 0; j <= 128; ++j) {
            if (tl - j * dil < 0) break;
            const size_t kr = (size_t)(row - j * dil) * 3072 + h * 128 + 2 * lane;
            const unsigned kk = *(const unsigned*)(QKV + kr + 1024), vv = *(const unsigned*)(QKV + kr + 2048);
            const float d = wave_sum(q0 * bf_lo(kk) + q1 * bf_hi(kk));
            const float sc = d * 0.08838834764831845f - slope * (float)j;
            const float mn = fmaxf(m, sc), f = __expf(m - mn), p = __expf(sc - mn);
            l = l * f + p; o0 = o0 * f + p * bf_lo(vv); o1 = o1 * f + p * bf_hi(vv); m = mn;
        }
        const float inv_l = 1.0f / l; const float lse_cur = m + __logf(l);
        float ca = 0.f, cb = inv_l, lse_new = lse_cur;
        float* lsep = LSE + (size_t)row * 8 + h;
        unsigned* op = (unsigned*)(O + (size_t)row * 1024 + h * 128 + 2 * lane);
        if (gi > 0) {
            const float lse_prev = *lsep; const float mm = fmaxf(lse_prev, lse_cur);
            const float wp = __expf(lse_prev - mm), wcur = __expf(lse_cur - mm), inv = 1.0f / (wp + wcur);
            ca = wp * inv; cb = wcur * inv * inv_l; lse_new = mm + __logf(wp + wcur);
            const unsigned pr = *op; o0 = o0 * cb + ca * bf_lo(pr); o1 = o1 * cb + ca * bf_hi(pr);
        } else { o0 *= cb; o1 *= cb; }
        *op = cvt_pk_bf16(o0, o1);
        if (lane == 0) *lsep = lse_new;
    }
}

__device__ __forceinline__ void conv_phase(const bf16_t* ZC, const bf16_t* GB, const float* cw, bf16_t* Y2, int gtid, int gthreads) {
    for (int it = gtid; it < (M_TOK / 8) * 128; it += gthreads) {
        const int oc = it & 127, t0 = (it >> 7) * 8, tl0 = t0 & (SEQ - 1);
        u32x4 Z[10], Gv[8];
#pragma unroll
        for (int k = 0; k < 10; ++k) Z[k] = (tl0 + k - 2 >= 0) ? *(const u32x4*)(ZC + (size_t)(t0 + k - 2) * 1024 + oc * 8) : (u32x4){0u, 0u, 0u, 0u};
#pragma unroll
        for (int k = 0; k < 8; ++k) Gv[k] = *(const u32x4*)(GB + (size_t)(t0 + k) * 1024 + oc * 8);
        float w0[8], w1[8], w2[8];
        { const f32x4 a0 = *(const f32x4*)(cw + oc * 8), a1 = *(const f32x4*)(cw + oc * 8 + 4), b0 = *(const f32x4*)(cw + 1024 + oc * 8), b1 = *(const f32x4*)(cw + 1024 + oc * 8 + 4),
                      c0 = *(const f32x4*)(cw + 2048 + oc * 8), c1 = *(const f32x4*)(cw + 2048 + oc * 8 + 4);
#pragma unroll
          for (int e = 0; e < 4; ++e) { w0[e] = a0[e]; w0[4 + e] = a1[e]; w1[e] = b0[e]; w1[4 + e] = b1[e]; w2[e] = c0[e]; w2[4 + e] = c1[e]; } }
#pragma unroll
        for (int i = 0; i < 8; ++i) {
            float z2[8], z1[8], z0[8], gg[8], o[8];
            unpack8(Z[i], z2); unpack8(Z[i + 1], z1); unpack8(Z[i + 2], z0); unpack8(Gv[i], gg);
#pragma unroll
            for (int e = 0; e < 8; ++e) o[e] = gg[e] * (w0[e] * z2[e] + w1[e] * z1[e] + w2[e] * z0[e]);
            u32x4 w4; w4.x = cvt_pk_bf16(o[0], o[1]); w4.y = cvt_pk_bf16(o[2], o[3]); w4.z = cvt_pk_bf16(o[4], o[5]); w4.w = cvt_pk_bf16(o[6], o[7]);
            *(u32x4*)(Y2 + (size_t)(t0 + i) * DI + 1024 + oc * 8) = w4;
        }
    }
}

constexpr int N_PHASES = 16;
__global__ void __launch_bounds__(512) hybrid_fwd(Args a) {
    extern __shared__ __attribute__((aligned(16))) unsigned char lds_raw[];
    LAS unsigned char* lds = (LAS unsigned char*)lds_raw;
    cg::grid_group grid = cg::this_grid();
    const int tid = threadIdx.x, lane = tid & 63, wave = __builtin_amdgcn_readfirstlane(tid >> 6);
    const int G = gridDim.x, bid = blockIdx.x;
    const int gw = bid * 8 + wave, NGW = G * 8;
    const int gtid = bid * 512 + tid, gthreads = G * 512;
    unsigned char* ws = a.ws;
    bf16_t* W1T = (bf16_t*)(ws + WS_W1T); bf16_t* W2T = (bf16_t*)(ws + WS_W2T); bf16_t* W3T = (bf16_t*)(ws + WS_W3T); bf16_t* W4T = (bf16_t*)(ws + WS_W4T);
    bf16_t* WSB = (bf16_t*)(ws + WS_WSB); float* LSE = (float*)(ws + WS_LSE);
    bf16_t* XN = (bf16_t*)(ws + WS_XN); bf16_t* X1 = (bf16_t*)(ws + WS_X1); bf16_t* Z1 = (bf16_t*)(ws + WS_Z1);
    bf16_t* QKV = (bf16_t*)(ws + WS_QKV); bf16_t* Y2 = (bf16_t*)(ws + WS_Y2); bf16_t* GBb = (bf16_t*)(ws + WS_GB);
    float* RS = (float*)(ws + WS_RS);
    bf16_t* Y1 = (bf16_t*)a.out;
    bf16_t* Ob = (bf16_t*)a.out;
    bf16_t* ZC = (bf16_t*)((unsigned char*)a.out + 32 * MiB);
    const int lo = a.ph_lo, hi = a.ph_hi;
#define IN(k) (lo <= (k) && (k) < hi)
    volatile LAS unsigned* MISC = (volatile LAS unsigned*)(lds + MISC_OFF);
    if (tid < 32) MISC[tid] = 0u;
    __syncthreads();
    const XcdBarrier gbar = xcd_barrier_post((unsigned*)(ws + WS_BAR), MISC + 8);
    if (a.ph_hi > 1000) grid.sync();
#define GSYNC() xcd_barrier(gbar)
#define SYNC(k) do { if (IN(k) && IN((k) + 1)) GSYNC(); } while (0)

    if (IN(0)) {
        for (int it = bid; it < 256; it += G) fold_item(a.even_w_in, a.even_pool_w, W1T, (LAS float*)lds, it, tid);
        __syncthreads();
        LAS float* scr = (LAS float*)(lds + wave * 16384);
        constexpr int I1 = 16 * 128, I2 = 0, I3 = 0, ITOT = I1;
#define T_DECODE(it_, T_) do { int r_ = (it_); \
            if (r_ < I1) { const int kb = r_ / 128, nbk = r_ % 128; T_ = TItem{a.even_w_in, W1T, EVEN_IN, DM, kb * 64, 1024 + nbk * 32, w1_dst_row(1024 + nbk * 32), nullptr}; } \
            else if ((r_ -= I1) < I2) { const int kb = r_ / 32, nbk = r_ % 32; T_ = TItem{a.even_w_out, W2T, DM, DI, kb * 64, nbk * 32, nbk * 32, nullptr}; } \
            else if ((r_ -= I2) < I3) { const int kb = r_ / 448, nbk = r_ % 448; T_ = TItem{a.odd_w_in, W3T, ODD_IN, DM, kb * 64, nbk * 32, w3_dst_row(nbk * 32), a.odd_norm}; } \
            else { r_ -= I3; const int kb = r_ / 32, nbk = r_ % 32; T_ = TItem{a.odd_w_out, W4T, DM, DI, kb * 64, nbk * 32, nbk * 32, nullptr}; } } while (0)
        if (gw < ITOT) {
            TItem cur; f32x4 vc[8]; T_DECODE(gw, cur); titem_load(cur, vc, lane);
            for (int it = gw; it < ITOT; it += NGW) {
                TItem nxt = cur; f32x4 vn[8]; const bool has = it + NGW < ITOT;
                if (has) { T_DECODE(it + NGW, nxt); titem_load(nxt, vn, lane); }
                titem_finish(cur, vc, scr, lane);
                if (has) { cur = nxt;
#pragma unroll
                    for (int i = 0; i < 8; ++i) vc[i] = vn[i]; }
            }
        }
#undef T_DECODE
        for (int i = gtid; i < 4 * 128 * 128; i += gthreads) { const int tt = (i >> 7) & 127, ss = i & 127; const float v = (ss <= tt) ? a.even_ws[i] : 0.f; WSB[i] = (bf16_t)(cvt_pk_bf16(v, 0.f) & 0xffffu); }
        for (int m = gw; m < M_TOK; m += 2 * NGW) rms_row2_bf16(a.x + (size_t)m * DM, a.x + (size_t)(m + NGW) * DM, a.even_norm, XN + (size_t)m * DM, XN + (size_t)(m + NGW) * DM, lane);
    }
    SYNC(0);
#ifdef EXP_BAR
    for (int q = 0; q < 10; ++q) GSYNC();
#endif
    if (IN(1)) { pg8::Gemm g{XN, W1T, M_TOK, EVEN_IN, DM}; pg8::StaticOrder S; S.init(M_TOK, EVEN_IN, G, bid); pg8::EpiEven E{Z1}; pg8::gemm_phase(lds, g, S, E, NoPend{}); }
    xcd_arrive(gbar); seam_convert<1>(a.even_w_out, a.odd_w_in, a.odd_norm, a.odd_w_out, W2T, W3T, W4T, (LAS float*)(lds + wave * 16384), gw, NGW, lane); xcd_wait(gbar);
    if (IN(2)) { ya_phase(Z1, a.even_pool_scale, Y1, gw, NGW, lane); yb_phase(lds, Z1, WSB, a.even_bs, Y1, G, bid); }
    xcd_arrive(gbar); seam_convert<2>(a.even_w_out, a.odd_w_in, a.odd_norm, a.odd_w_out, W2T, W3T, W4T, (LAS float*)(lds + wave * 16384), gw, NGW, lane);
    if (IN(3)) { pg8::Gemm g{Y1, W2T, M_TOK, DM, DI}; pg8::StaticOrder S; S.init(M_TOK, DM, G, bid);
        pg8::EpiResNorm<true> E{a.x, nullptr, X1, RS, nullptr, a.odd_norm, pg8::PanelSq{(float*)(ws + WS_XB0), (unsigned*)(ws + WS_CNT0)}}; pg8::gemm_phase(lds, g, S, E, EarlyPend{&gbar}); }
    xcd_arrive(gbar); seam_convert<3>(a.even_w_out, a.odd_w_in, a.odd_norm, a.odd_w_out, W2T, W3T, W4T, (LAS float*)(lds + wave * 16384), gw, NGW, lane); xcd_wait(gbar);
    if (IN(5)) { pg8::Gemm g{X1, W3T, M_TOK, 3072, DM}; pg8::StaticOrder S; S.init(M_TOK, 3072, G, bid); pg8::EpiBf16 E{QKV, 3072, RS}; pg8::gemm_phase(lds, g, S, E, NoPend{}); }
    xcd_arrive(gbar); seam_convert<4>(a.even_w_out, a.odd_w_in, a.odd_norm, a.odd_w_out, W2T, W3T, W4T, (LAS float*)(lds + wave * 16384), gw, NGW, lane); xcd_wait(gbar);
    attn_group_phase<0>(lds, QKV, Ob, LSE, G, bid);
    xcd_arrive(gbar);
    { pg8::Gemm g{X1, W3T + (size_t)3072 * DM, M_TOK, 3072, DM}; pg8::StaticOrder S; S.init(M_TOK, 3072, G, bid); pg8::EpiBf16 E{QKV, 3072, RS}; pg8::gemm_phase(lds, g, S, E, BarPend{&gbar}); }
    xcd_arrive(gbar); seam_convert<5>(a.even_w_out, a.odd_w_in, a.odd_norm, a.odd_w_out, W2T, W3T, W4T, (LAS float*)(lds + wave * 16384), gw, NGW, lane); xcd_wait(gbar);
    attn_group_phase<1>(lds, QKV, Ob, LSE, G, bid);
    xcd_arrive(gbar);
    { pg8::Gemm g{X1, W3T + (size_t)2 * 3072 * DM, M_TOK, 5120, DM}; pg8::StaticOrder S; S.init(M_TOK, 5120, G, bid);
        pg8::EpiQkvZc E{pg8::EpiBf16{QKV, 3072, RS}, pg8::EpiPair{ZC, GBb, RS}}; pg8::gemm_phase(lds, g, S, E, BarPend{&gbar}); }
    GSYNC();
    attn_group_phase<2>(lds, QKV, Ob, LSE, G, bid);
    xcd_arrive(gbar);
    { pg8::Gemm g{X1, W3T + (size_t)11264 * DM, M_TOK, 3072, DM}; pg8::StaticOrder S; S.init(M_TOK, 3072, G, bid);
        pg8::EpiGcGb E{pg8::EpiGateMul{Ob, 1024, Y2, DI, RS}, pg8::EpiGateConv{ZC, a.odd_conv_w, Y2, RS}}; pg8::gemm_phase(lds, g, S, E, BarPend{&gbar}); }
    xcd_arrive(gbar);
    if (IN(14)) { pg8::Gemm g{Y2, W4T, M_TOK, DM, DI}; pg8::StaticOrder S; S.init(M_TOK, DM, G, bid);
        pg8::EpiResNorm<false> E{nullptr, X1, nullptr, nullptr, a.out, a.final_norm, pg8::PanelSq{(float*)(ws + WS_XB1), (unsigned*)(ws + WS_CNT1)}}; pg8::gemm_phase(lds, g, S, E, EarlyPend{&gbar}); }
#undef IN
#undef SYNC
}

extern "C" void kernel_launch(void* const* d_in, const int* in_sizes, int n_in, void* d_out, int out_size, void* d_ws, size_t ws_size, hipStream_t stream) {
    static int grid = 0;
    if (grid == 0) {
        int dev = 0, cus = 0, per_cu = 0;
        hipGetDevice(&dev);
        hipDeviceGetAttribute(&cus, hipDeviceAttributeMultiprocessorCount, dev);
        hipFuncSetAttribute((const void*)hybrid_fwd, hipFuncAttributeMaxDynamicSharedMemorySize, LDS_BYTES);
        if (hipOccupancyMaxActiveBlocksPerMultiprocessor(&per_cu, (const void*)hybrid_fwd, 512, LDS_BYTES) != hipSuccess || per_cu < 1) per_cu = 1;
        (void)hipGetLastError();
        grid = cus * per_cu;
        if (grid <= 0) grid = 256;
    }
    Args a{};
    a.x = (const float*)d_in[0]; a.even_norm = (const float*)d_in[1]; a.even_w_in = (const float*)d_in[2]; a.even_pool_w = (const float*)d_in[3];
    a.even_pool_scale = (const float*)d_in[4]; a.even_ws = (const float*)d_in[5]; a.even_bs = (const float*)d_in[6]; a.even_w_out = (const float*)d_in[7];
    a.odd_norm = (const float*)d_in[8]; a.odd_w_in = (const float*)d_in[9]; a.odd_conv_w = (const float*)d_in[10]; a.odd_w_out = (const float*)d_in[11];
    a.final_norm = (const float*)d_in[12];
    a.out = (float*)d_out; a.ws = (unsigned char*)d_ws; a.ph_lo = 0; a.ph_hi = N_PHASES;
    (void)hipMemsetAsync((char*)d_ws + WS_BAR, 0, 49152, stream);
    void* args[] = {&a};
    hipError_t e = hipLaunchCooperativeKernel((const void*)hybrid_fwd, dim3(grid), dim3(512), args, LDS_BYTES, stream);
    if (e != hipSuccess) fprintf(stderr, "cooperative launch failed: %s (grid %d)\n", hipGetErrorString(e), grid);
}
```

```cpp
#define NAIVE_ATTN 0

#include <hip/hip_runtime.h>
#include <hip/hip_cooperative_groups.h>
#include <cstdio>
#include <cstdint>
namespace cg = cooperative_groups;

#define LAS __attribute__((address_space(3)))
typedef unsigned short bf16_t;
typedef short bf16x8 __attribute__((ext_vector_type(8)));
typedef short s16x4 __attribute__((ext_vector_type(4)));
typedef float f32x4 __attribute__((ext_vector_type(4)));
typedef float f32x2 __attribute__((ext_vector_type(2)));
typedef unsigned u32x4 __attribute__((ext_vector_type(4)));
typedef unsigned u32x2 __attribute__((ext_vector_type(2)));

constexpr int M_TOK = 16384, SEQ = 8192, DM = 1024;
constexpr int EVEN_IN = 5120, ODD_IN = 14336, DI = 2048, ZP = 4096;
constexpr float EPS = 1e-6f;
constexpr size_t MiB = 1u << 20;
constexpr size_t WS_W1T = 0, WS_W2T = 10 * MiB, WS_W3T = 14 * MiB, WS_W4T = 42 * MiB, WS_WSB = 46 * MiB, WS_LSE = 47 * MiB;
constexpr size_t WS_XN = 48 * MiB, WS_X1 = 80 * MiB, WS_Z1 = 80 * MiB, WS_QKV = 144 * MiB, WS_Y2 = 144 * MiB, WS_GB = 208 * MiB;
constexpr int LDS_BYTES = 147456;

typedef __bf16 bf16x2_t __attribute__((ext_vector_type(2)));
__device__ __forceinline__ unsigned cvt_pk_bf16(float lo, float hi) { f32x2 v = {lo, hi}; bf16x2_t b = __builtin_convertvector(v, bf16x2_t); return __builtin_bit_cast(unsigned, b); }
__device__ __forceinline__ float bf_lo(unsigned u) { return __uint_as_float(u << 16); }
__device__ __forceinline__ float bf_hi(unsigned u) { return __uint_as_float(u & 0xffff0000u); }
__device__ __forceinline__ float silu_f(float x) { return x * __builtin_amdgcn_rcpf(1.0f + __expf(-x)); }
__device__ __forceinline__ float wave_sum(float v) {
#pragma unroll
    for (int o = 1; o < 64; o <<= 1) v += __shfl_xor(v, o);
    return v;
}
__device__ __forceinline__ s16x4 tr_read(const LAS unsigned char* p) {
    typedef short v4i16_t __attribute__((ext_vector_type(4)));
    return __builtin_bit_cast(s16x4, __builtin_amdgcn_ds_read_tr16_b64_v4i16((LAS v4i16_t*)p));
}
__device__ __forceinline__ bf16x8 cat8(s16x4 lo, s16x4 hi) { return (bf16x8){lo[0], lo[1], lo[2], lo[3], hi[0], hi[1], hi[2], hi[3]}; }

namespace pg8 {
constexpr int BM = 256, BK = 64, HALF = 128, HTB = HALF * BK * 2, STAGE_BYTES = 8 * HTB, NXCD = 8, WGM = 8;
__host__ __device__ __forceinline__ int lds_byte(int r, int c) { const int st = (r >> 4) * 2 + (c >> 5), rr = r & 15, cc = c & 31, ob = rr * 64 + cc * 2; return st * 1024 + (ob ^ (((ob >> 9) & 1) << 5)); }
__host__ __device__ __forceinline__ void stage_rc(int b, int& R, int& C) { const int st = b / 1024, sb = b % 1024, swz = sb ^ (((sb >> 9) & 1) << 5); R = (st >> 1) * 16 + swz / 64; C = (st & 1) * 32 + (swz % 64) / 2; }
__host__ __device__ __forceinline__ int perm32(int rho) { const int n = rho >> 4, i = rho & 15; return 8 * (i >> 2) + 4 * n + (i & 3); }

struct Unit { int pm, pn; };
struct Gemm { const bf16_t* A; const bf16_t* Bt; int M, N, K; };

struct StaticOrder {
    int nM, nN, nwg, G, c;
    __host__ __device__ void init(int M, int N, int G_, int c_) { nM = M / BM; nN = N / BM; nwg = nM * nN; G = G_; c = c_; }
    __host__ __device__ bool next(int i, Unit& u) const {
        const long L = (long)i * G + c; if (L >= nwg) return false;
        int wgid = (int)L; { const int q = nwg / NXCD, r = nwg % NXCD, xcd = wgid % NXCD, off = wgid / NXCD; wgid = (xcd < r ? xcd * (q + 1) : r * (q + 1) + (xcd - r) * q) + off; }
        const int nig = WGM * nN, gid = wgid / nig, fm = gid * WGM, gsz = (nM - fm) < WGM ? (nM - fm) : WGM;
        u.pm = fm + ((wgid % nig) % gsz); u.pn = (wgid % nig) / gsz; return true;
    }
};

struct EpiBf16 {
    static constexpr bool AFTER_DRAIN = false; static constexpr bool HAS_INIT = false;
    static constexpr bool PERM = true;
    bf16_t* O; int ldc;
    __device__ __forceinline__ void operator()(const f32x4 (&acc)[2][2][4][2], const Unit& u, int wr, int wc, int fr, int fq) const {
        const int row0 = u.pm * BM + wr * 64 + fr; const int col0 = u.pn * BM + wc * 32 + 8 * fq;
#pragma unroll
        for (int ai = 0; ai < 2; ++ai)
#pragma unroll
            for (int m = 0; m < 4; ++m) { bf16_t* rowp = O + (size_t)(row0 + ai * HALF + m * 16) * ldc + col0;
#pragma unroll
                for (int bj = 0; bj < 2; ++bj) { const f32x4 v0 = acc[ai][bj][m][0], v1 = acc[ai][bj][m][1];
                    u32x4 w; w.x = cvt_pk_bf16(v0[0], v0[1]); w.y = cvt_pk_bf16(v0[2], v0[3]); w.z = cvt_pk_bf16(v1[0], v1[1]); w.w = cvt_pk_bf16(v1[2], v1[3]);
                    *(u32x4*)(rowp + bj * HALF) = w; } }
    }
};
struct EpiResF32 {
    static constexpr bool AFTER_DRAIN = false; static constexpr bool HAS_INIT = false;
    static constexpr bool PERM = false;
    const float* base; float* out; int ldc;
    __device__ __forceinline__ void operator()(const f32x4 (&acc)[2][2][4][2], const Unit& u, int wr, int wc, int fr, int fq) const {
        const int col0 = u.pn * BM + wc * 32 + 4 * fq;
#pragma unroll
        for (int ai = 0; ai < 2; ++ai)
#pragma unroll
            for (int m = 0; m < 4; ++m) { const size_t off = (size_t)(u.pm * BM + ai * HALF + wr * 64 + m * 16 + fr) * ldc + col0;
#pragma unroll
                for (int bj = 0; bj < 2; ++bj)
#pragma unroll
                    for (int n = 0; n < 2; ++n) { const f32x4 bs = *(const f32x4*)(base + off + bj * HALF + n * 16); *(f32x4*)(out + off + bj * HALF + n * 16) = bs + acc[ai][bj][m][n]; } }
    }
};
struct EpiGateMul {
    static constexpr bool AFTER_DRAIN = false; static constexpr bool HAS_INIT = false;
    static constexpr bool PERM = true;
    const bf16_t* Oin; int ldo; bf16_t* Y; int ldy;
    __device__ __forceinline__ void operator()(const f32x4 (&acc)[2][2][4][2], const Unit& u, int wr, int wc, int fr, int fq) const {
        const int row0 = u.pm * BM + wr * 64 + fr; const int col0 = u.pn * BM + wc * 32 + 8 * fq;
#pragma unroll
        for (int ai = 0; ai < 2; ++ai)
#pragma unroll
            for (int m = 0; m < 4; ++m) { const size_t row = (size_t)(row0 + ai * HALF + m * 16);
#pragma unroll
                for (int bj = 0; bj < 2; ++bj) { const f32x4 v0 = acc[ai][bj][m][0], v1 = acc[ai][bj][m][1];
                    const u32x4 o = *(const u32x4*)(Oin + row * ldo + col0 + bj * HALF);
                    u32x4 w;
                    w.x = cvt_pk_bf16(bf_lo(o.x) * silu_f(v0[0]), bf_hi(o.x) * silu_f(v0[1])); w.y = cvt_pk_bf16(bf_lo(o.y) * silu_f(v0[2]), bf_hi(o.y) * silu_f(v0[3]));
                    w.z = cvt_pk_bf16(bf_lo(o.z) * silu_f(v1[0]), bf_hi(o.z) * silu_f(v1[1])); w.w = cvt_pk_bf16(bf_lo(o.w) * silu_f(v1[2]), bf_hi(o.w) * silu_f(v1[3]));
                    *(u32x4*)(Y + row * ldy + col0 + bj * HALF) = w; } }
    }
};
struct EpiPair {
    static constexpr bool AFTER_DRAIN = false; static constexpr bool HAS_INIT = false;
    static constexpr bool PERM = true;
    bf16_t* ZC; bf16_t* GB;
    __device__ __forceinline__ void operator()(const f32x4 (&acc)[2][2][4][2], const Unit& u, int wr, int wc, int fr, int fq) const {
        const int row0 = u.pm * BM + wr * 64 + fr; const bool gate = u.pn >= 8; const int ct = gate ? u.pn - 8 : u.pn;
        bf16_t* dst = (gate ? GB : ZC) + ct * 128 + wc * 32 + 8 * fq;
#pragma unroll
        for (int ai = 0; ai < 2; ++ai)
#pragma unroll
            for (int m = 0; m < 4; ++m) { const size_t row = (size_t)(row0 + ai * HALF + m * 16);
                f32x4 p0 = acc[ai][0][m][0], p1 = acc[ai][0][m][1], q0 = acc[ai][1][m][0], q1 = acc[ai][1][m][1];
                if (gate) {
#pragma unroll
                    for (int e = 0; e < 4; ++e) { q0[e] = silu_f(q0[e]); q1[e] = silu_f(q1[e]); } }
                p0 = p0 * q0; p1 = p1 * q1;
                u32x4 w; w.x = cvt_pk_bf16(p0[0], p0[1]); w.y = cvt_pk_bf16(p0[2], p0[3]); w.z = cvt_pk_bf16(p1[0], p1[1]); w.w = cvt_pk_bf16(p1[2], p1[3]);
                *(u32x4*)(dst + row * 1024) = w; }
    }
};


struct EpiGateConv {
    static constexpr bool AFTER_DRAIN = false; static constexpr bool HAS_INIT = false;
    static constexpr bool PERM = true;
    const bf16_t* ZC; const float* cw; bf16_t* Y2;
    __device__ __forceinline__ void operator()(const f32x4 (&acc)[2][2][4][2], const Unit& u, int wr, int wc, int fr, int fq) const {
        const int row0 = u.pm * BM + wr * 64 + fr; const int ch0 = u.pn * 128 + wc * 32 + 8 * fq;
        const f32x4 wa0 = *(const f32x4*)(cw + ch0), wa1 = *(const f32x4*)(cw + ch0 + 4), wb0 = *(const f32x4*)(cw + 1024 + ch0), wb1 = *(const f32x4*)(cw + 1024 + ch0 + 4),
                    wc0 = *(const f32x4*)(cw + 2048 + ch0), wc1 = *(const f32x4*)(cw + 2048 + ch0 + 4);
#pragma unroll
        for (int ai = 0; ai < 2; ++ai)
#pragma unroll
            for (int m = 0; m < 4; ++m) { const int row = row0 + ai * HALF + m * 16; const int tl = row & (SEQ - 1);
                const bf16_t* zp = ZC + (size_t)row * 1024 + ch0;
                const u32x4 z0 = *(const u32x4*)zp;
                const u32x4 z1 = (tl >= 1) ? *(const u32x4*)(zp - 1024) : (u32x4){0u, 0u, 0u, 0u};
                const u32x4 z2 = (tl >= 2) ? *(const u32x4*)(zp - 2048) : (u32x4){0u, 0u, 0u, 0u};
                f32x4 p0 = acc[ai][0][m][0], p1 = acc[ai][0][m][1]; const f32x4 q0 = acc[ai][1][m][0], q1 = acc[ai][1][m][1];
#pragma unroll
                for (int e = 0; e < 4; ++e) { p0[e] *= silu_f(q0[e]); p1[e] *= silu_f(q1[e]); }
                const f32x4 a0 = {bf_lo(z0.x), bf_hi(z0.x), bf_lo(z0.y), bf_hi(z0.y)}, a1 = {bf_lo(z0.z), bf_hi(z0.z), bf_lo(z0.w), bf_hi(z0.w)};
                const f32x4 b0 = {bf_lo(z1.x), bf_hi(z1.x), bf_lo(z1.y), bf_hi(z1.y)}, b1 = {bf_lo(z1.z), bf_hi(z1.z), bf_lo(z1.w), bf_hi(z1.w)};
                const f32x4 c0 = {bf_lo(z2.x), bf_hi(z2.x), bf_lo(z2.y), bf_hi(z2.y)}, c1 = {bf_lo(z2.z), bf_hi(z2.z), bf_lo(z2.w), bf_hi(z2.w)};
                p0 = p0 * (wa0 * c0 + wb0 * b0 + wc0 * a0); p1 = p1 * (wa1 * c1 + wb1 * b1 + wc1 * a1);
                u32x4 w; w.x = cvt_pk_bf16(p0[0], p0[1]); w.y = cvt_pk_bf16(p0[2], p0[3]); w.z = cvt_pk_bf16(p1[0], p1[1]); w.w = cvt_pk_bf16(p1[2], p1[3]);
                *(u32x4*)(Y2 + (size_t)row * DI + 1024 + ch0) = w; }
    }
};

struct EpiQkvZc {
    static constexpr bool AFTER_DRAIN = false, PERM = true, HAS_INIT = false;
    EpiBf16 e0; EpiPair e1;
    __device__ __forceinline__ void operator()(const f32x4 (&acc)[2][2][4][2], const Unit& u, int wr, int wc, int fr, int fq) const {
        if (u.pn < 12) e0(acc, u, wr, wc, fr, fq); else { Unit v = u; v.pn -= 12; e1(acc, v, wr, wc, fr, fq); }
    }
};
struct EpiGcGb {
    static constexpr bool AFTER_DRAIN = false, PERM = true, HAS_INIT = false;
    EpiGateMul e0; EpiGateConv e1;
    __device__ __forceinline__ void operator()(const f32x4 (&acc)[2][2][4][2], const Unit& u, int wr, int wc, int fr, int fq) const {
        if (u.pn < 4) e0(acc, u, wr, wc, fr, fq); else { Unit v = u; v.pn -= 4; e1(acc, v, wr, wc, fr, fq); }
    }
};

struct EpiEven {
    static constexpr bool AFTER_DRAIN = false, PERM = true, HAS_INIT = false;
    bf16_t* Z;
    __device__ __forceinline__ void operator()(const f32x4 (&acc)[2][2][4][2], const Unit& u, int wr, int wc, int fr, int fq) const {
        const int row0 = u.pm * BM + wr * 64 + fr;
        if (u.pn < 12) {
            const bool act = (u.pn >= 4) && (u.pn < 8); const int col0 = u.pn * BM + wc * 32 + 8 * fq;
#pragma unroll
            for (int ai = 0; ai < 2; ++ai)
#pragma unroll
                for (int m = 0; m < 4; ++m) { bf16_t* rowp = Z + (size_t)(row0 + ai * HALF + m * 16) * ZP + col0;
#pragma unroll
                    for (int bj = 0; bj < 2; ++bj) { f32x4 v0 = acc[ai][bj][m][0], v1 = acc[ai][bj][m][1];
                        if (act) {
#pragma unroll
                            for (int e = 0; e < 4; ++e) { v0[e] = silu_f(v0[e]); v1[e] = silu_f(v1[e]); } }
                        u32x4 w; w.x = cvt_pk_bf16(v0[0], v0[1]); w.y = cvt_pk_bf16(v0[2], v0[3]); w.z = cvt_pk_bf16(v1[0], v1[1]); w.w = cvt_pk_bf16(v1[2], v1[3]);
                        *(u32x4*)(rowp + bj * HALF) = w; } }
        } else {
            bf16_t* dst = Z + 3072 + (u.pn - 12) * 128 + wc * 32 + 8 * fq;
#pragma unroll
            for (int ai = 0; ai < 2; ++ai)
#pragma unroll
                for (int m = 0; m < 4; ++m) { const size_t row = (size_t)(row0 + ai * HALF + m * 16);
                    f32x4 p0 = acc[ai][0][m][0], p1 = acc[ai][0][m][1]; const f32x4 q0 = acc[ai][1][m][0], q1 = acc[ai][1][m][1];
#pragma unroll
                    for (int e = 0; e < 4; ++e) { p0[e] *= silu_f(q0[e]); p1[e] *= silu_f(q1[e]); }
                    u32x4 w; w.x = cvt_pk_bf16(p0[0], p0[1]); w.y = cvt_pk_bf16(p0[2], p0[3]); w.z = cvt_pk_bf16(p1[0], p1[1]); w.w = cvt_pk_bf16(p1[2], p1[3]);
                    *(u32x4*)(dst + row * ZP) = w; }
        }
    }
};

struct PanelSq {
    float* xbuf;
    unsigned* cnt;
    __device__ __forceinline__ void run(const f32x4 (&v)[2][2][4][2], const Unit& u, int wr, int wc, int fr, int fq, LAS unsigned char* lds, int wid, int lane) const {
        LAS float* P = (LAS float*)lds;
        LAS float* S = (LAS float*)(lds + 4096);
#pragma unroll
        for (int ai = 0; ai < 2; ++ai)
#pragma unroll
            for (int m = 0; m < 4; ++m) {
                float q = 0.f;
#pragma unroll
                for (int bj = 0; bj < 2; ++bj)
#pragma unroll
                    for (int n = 0; n < 2; ++n) { const f32x4 x = v[ai][bj][m][n]; q += (x[0] * x[0] + x[1] * x[1]) + (x[2] * x[2] + x[3] * x[3]); }
                q += __shfl_xor(q, 16); q += __shfl_xor(q, 32);
                if (fq == 0) P[(ai * HALF + wr * 64 + m * 16 + fr) * 4 + wc] = q;
            }
        asm volatile("s_waitcnt lgkmcnt(0)" ::: "memory"); __builtin_amdgcn_s_barrier(); asm volatile("" ::: "memory");
        const int row = wid * 64 + lane;
        if (wid < 4) {
            const float tot = (P[row * 4 + 0] + P[row * 4 + 1]) + (P[row * 4 + 2] + P[row * 4 + 3]);
            __hip_atomic_store(xbuf + (size_t)(u.pm * BM + row) * 4 + u.pn, tot, __ATOMIC_RELAXED, __HIP_MEMORY_SCOPE_AGENT);
        }
        asm volatile("s_waitcnt vmcnt(0)" ::: "memory");
        if (wid < 4 && lane == 0) __hip_atomic_fetch_add(cnt + 64 * u.pm, 1u, __ATOMIC_RELAXED, __HIP_MEMORY_SCOPE_AGENT);
        if (wid == 0) {
            unsigned sp = 0;
            while ((unsigned)__builtin_amdgcn_readfirstlane(__hip_atomic_load(cnt + 64 * u.pm, __ATOMIC_RELAXED, __HIP_MEMORY_SCOPE_AGENT)) < 16u) { __builtin_amdgcn_s_sleep(2); if (++sp > (1u << 22)) break; }
            __builtin_amdgcn_fence(__ATOMIC_ACQUIRE, "agent");
        }
        asm volatile("s_waitcnt vmcnt(0) lgkmcnt(0)" ::: "memory"); __builtin_amdgcn_s_barrier(); asm volatile("" ::: "memory");
        if (wid < 4) {
            const float* slot = xbuf + (size_t)(u.pm * BM + row) * 4;
            const float a0 = __hip_atomic_load(slot + 0, __ATOMIC_RELAXED, __HIP_MEMORY_SCOPE_AGENT), a1 = __hip_atomic_load(slot + 1, __ATOMIC_RELAXED, __HIP_MEMORY_SCOPE_AGENT);
            const float a2 = __hip_atomic_load(slot + 2, __ATOMIC_RELAXED, __HIP_MEMORY_SCOPE_AGENT), a3 = __hip_atomic_load(slot + 3, __ATOMIC_RELAXED, __HIP_MEMORY_SCOPE_AGENT);
            S[row] = rsqrtf(((a0 + a1) + (a2 + a3)) * (1.f / 1024.f) + 1e-6f);
        }
        asm volatile("s_waitcnt lgkmcnt(0)" ::: "memory"); __builtin_amdgcn_s_barrier(); asm volatile("" ::: "memory");
    }
};
template <bool WRITE_X  >
struct EpiResNorm {
    static constexpr bool PERM = true, AFTER_DRAIN = true, HAS_INIT = true; static constexpr int NSTORES = 0;
    const float* base; const bf16_t* base16; bf16_t* xout; bf16_t* xn; float* nout; const float* g; PanelSq st;
    __device__ __forceinline__ void init(f32x4 (&acc)[2][2][4][2], const Unit& u, int wr, int wc, int fr, int fq) const {
        const int col0 = u.pn * BM + wc * 32 + 8 * fq;
#pragma unroll
        for (int ai = 0; ai < 2; ++ai)
#pragma unroll
            for (int m = 0; m < 4; ++m) { const size_t off = (size_t)(u.pm * BM + ai * HALF + wr * 64 + m * 16 + fr) * 1024 + col0;
#pragma unroll
                for (int bj = 0; bj < 2; ++bj) {
                    if (WRITE_X) { acc[ai][bj][m][0] = *(const f32x4*)(base + off + bj * HALF); acc[ai][bj][m][1] = *(const f32x4*)(base + off + bj * HALF + 4); }
                    else { const u32x4 b4 = *(const u32x4*)(base16 + off + bj * HALF);
                        acc[ai][bj][m][0] = (f32x4){bf_lo(b4.x), bf_hi(b4.x), bf_lo(b4.y), bf_hi(b4.y)}; acc[ai][bj][m][1] = (f32x4){bf_lo(b4.z), bf_hi(b4.z), bf_lo(b4.w), bf_hi(b4.w)}; } } }
    }
    __device__ __forceinline__ void fused(f32x4 (&acc)[2][2][4][2], const Unit& u, int wr, int wc, int fr, int fq, LAS unsigned char* lds, int wid, int lane) const {
        const int col0 = u.pn * BM + wc * 32 + 8 * fq;
        st.run(acc, u, wr, wc, fr, fq, lds, wid, lane);
        const LAS float* S = (const LAS float*)(lds + 4096);
        f32x4 gv[2][2];
#pragma unroll
        for (int bj = 0; bj < 2; ++bj)
#pragma unroll
            for (int n = 0; n < 2; ++n) gv[bj][n] = *(const f32x4*)(g + col0 + bj * HALF + n * 4);
#pragma unroll
        for (int ai = 0; ai < 2; ++ai)
#pragma unroll
            for (int m = 0; m < 4; ++m) { const int r = ai * HALF + wr * 64 + m * 16 + fr; const float rstd = S[r]; const size_t off = (size_t)(u.pm * BM + r) * 1024 + col0;
#pragma unroll
                for (int bj = 0; bj < 2; ++bj) { const f32x4 x0 = acc[ai][bj][m][0], x1 = acc[ai][bj][m][1]; const f32x4 y0 = x0 * rstd * gv[bj][0], y1 = x1 * rstd * gv[bj][1];
                    if (WRITE_X) { u32x4 xw; xw.x = cvt_pk_bf16(x0[0], x0[1]); xw.y = cvt_pk_bf16(x0[2], x0[3]); xw.z = cvt_pk_bf16(x1[0], x1[1]); xw.w = cvt_pk_bf16(x1[2], x1[3]); *(u32x4*)(xout + off + bj * HALF) = xw;
                        u32x4 w; w.x = cvt_pk_bf16(y0[0], y0[1]); w.y = cvt_pk_bf16(y0[2], y0[3]); w.z = cvt_pk_bf16(y1[0], y1[1]); w.w = cvt_pk_bf16(y1[2], y1[3]); *(u32x4*)(xn + off + bj * HALF) = w; }
                    else { *(f32x4*)(nout + off + bj * HALF) = y0; *(f32x4*)(nout + off + bj * HALF + 4) = y1; } } }
    }
};

template <class Epi, class Sched, class Pend>
__device__ __forceinline__ void gemm_phase(LAS unsigned char* lds, const Gemm g, const Sched& S, const Epi& E, const Pend& pend) {
    int tid = threadIdx.x; asm volatile("" : "+v"(tid));
    const int wid = __builtin_amdgcn_readfirstlane(tid >> 6), lane = tid & 63, wr = wid >> 2, wc = wid & 3, fr = lane & 15, fq = lane >> 4;
    const int K = g.K, nt = K / BK;
    unsigned voffA[2], voffB[2];
#pragma unroll
    for (int i = 0; i < 2; ++i) { int R, C; stage_rc(tid * 16 + i * 8192, R, C); const int Rb = Epi::PERM ? ((R & ~31) + perm32(R & 31)) : R;
        voffA[i] = (unsigned)(R * K + C) * 2u; voffB[i] = (unsigned)(tid * 16 + i * 8192); (void)Rb; }
    const size_t kstep = (size_t)(BK * 2);
    const size_t kstepB = (size_t)HTB;
    const size_t hstep = (size_t)HALF * K * 2;
    const size_t tstep = 2 * hstep;
    const unsigned ldsw = (unsigned)wid * 1024u;
    const int aoff = lds_byte(wr * 64 + fr, fq * 8), boff = lds_byte(wc * 32 + fr, fq * 8);
#define PG8_SA(b, h) (((b) * 2 + (h)) * HTB)
#define PG8_SB(b, h) ((4 + (b) * 2 + (h)) * HTB)
#define PG8_STAGE(bufoff, gbase, voff) do { _Pragma("unroll") for (int _i = 0; _i < 2; ++_i) \
        __builtin_amdgcn_global_load_lds((const unsigned*)((const char*)(gbase) + (voff)[_i]), (LAS unsigned*)(lds + (bufoff) + ldsw + _i * 8192), 16, 0, 0); } while (0)
#define PG8_LDA(dst, b, h) do { _Pragma("unroll") for (int m = 0; m < 4; ++m) _Pragma("unroll") for (int k = 0; k < 2; ++k) dst[m][k] = *(const LAS bf16x8*)(lds + PG8_SA(b, h) + aoff + m * 2048 + k * 1024); } while (0)
#define PG8_LDB(dst, b, h) do { _Pragma("unroll") for (int n = 0; n < 2; ++n) _Pragma("unroll") for (int k = 0; k < 2; ++k) dst[n][k] = *(const LAS bf16x8*)(lds + PG8_SB(b, h) + boff + n * 2048 + k * 1024); } while (0)
#define PG8_MMA(ai, bj, At, Bt) do { __builtin_amdgcn_s_setprio(1); _Pragma("unroll") for (int m = 0; m < 4; ++m) _Pragma("unroll") for (int n = 0; n < 2; ++n) _Pragma("unroll") for (int k = 0; k < 2; ++k) \
        acc[ai][bj][m][n] = __builtin_amdgcn_mfma_f32_16x16x32_bf16(Bt[n][k], At[m][k], acc[ai][bj][m][n], 0, 0, 0); __builtin_amdgcn_s_setprio(0); } while (0)
#define PG8_WAIT_V(n) asm volatile("s_waitcnt vmcnt(" #n ")" ::: "memory")
#define PG8_WAIT_L(n) asm volatile("s_waitcnt lgkmcnt(" #n ")" ::: "memory")
#define PG8_BAR __builtin_amdgcn_s_barrier()
#define PG8_SCHED __builtin_amdgcn_sched_barrier(0)
    Unit cur, nxt; int ui = 0;
    if (!S.next(0, cur)) return;
    f32x4 acc[2][2][4][2];
    if constexpr (Epi::HAS_INIT) E.init(acc, cur, wr, wc, fr, fq);
    else {
#pragma unroll
        for (int a = 0; a < 2; ++a)
#pragma unroll
            for (int b = 0; b < 2; ++b)
#pragma unroll
                for (int m = 0; m < 4; ++m)
#pragma unroll
                    for (int n = 0; n < 2; ++n) acc[a][b][m][n] = (f32x4){0.f, 0.f, 0.f, 0.f};
    }
    pend.early();
    bf16x8 At[4][2], B0[2][2], B1[2][2];
    const char* cA = (const char*)g.A + (size_t)cur.pm * tstep; const char* cB = (const char*)g.Bt + (size_t)cur.pn * tstep;
    PG8_STAGE(PG8_SB(0, 0), cB, voffB); PG8_STAGE(PG8_SB(0, 1), cB + hstep, voffB); PG8_STAGE(PG8_SA(0, 0), cA, voffA); PG8_STAGE(PG8_SA(0, 1), cA + hstep, voffA);
    if (wr == 1) PG8_BAR;
    PG8_WAIT_V(2); PG8_BAR;
    PG8_STAGE(PG8_SB(1, 0), cB + kstepB, voffB); PG8_STAGE(PG8_SA(1, 0), cA + kstep, voffA); PG8_STAGE(PG8_SB(1, 1), cB + hstep + kstepB, voffB);
    PG8_WAIT_V(6); PG8_BAR;
    for (;;) {
        const bool has_next = S.next(ui + 1, nxt);
        const char* nA = has_next ? (const char*)g.A + (size_t)nxt.pm * tstep : cA; const char* nB = has_next ? (const char*)g.Bt + (size_t)nxt.pn * tstep : cB;
        for (int t = 0; t < nt; t += 2) {
            const bool last = (t == nt - 2);
            const char* a1 = cA + (size_t)(t + 1) * kstep;
            const char* a2 = last ? nA : cA + (size_t)(t + 2) * kstep; const char* b2 = last ? nB : cB + (size_t)(t + 2) * kstepB;
            const char* a3 = a2 + kstep; const char* b3 = b2 + kstepB;
            PG8_LDB(B0, 0, 0); PG8_LDB(B1, 0, 1); PG8_SCHED; PG8_LDA(At, 0, 0); PG8_STAGE(PG8_SA(1, 1), a1 + hstep, voffA);
            PG8_WAIT_V(8); PG8_WAIT_L(0); PG8_BAR; PG8_MMA(0, 0, At, B0); PG8_MMA(0, 1, At, B1); PG8_BAR; PG8_SCHED;
            PG8_LDA(At, 0, 1); PG8_STAGE(PG8_SB(0, 0), b2, voffB); PG8_STAGE(PG8_SB(0, 1), b2 + hstep, voffB); PG8_STAGE(PG8_SA(0, 0), a2, voffA);
            PG8_WAIT_V(8); PG8_WAIT_L(0); PG8_BAR; PG8_MMA(1, 0, At, B0); PG8_MMA(1, 1, At, B1); PG8_BAR; PG8_SCHED;
            PG8_LDB(B0, 1, 0); PG8_LDB(B1, 1, 1); PG8_SCHED; PG8_LDA(At, 1, 0); PG8_STAGE(PG8_SA(0, 1), a2 + hstep, voffA);
            PG8_WAIT_V(8); PG8_WAIT_L(0); PG8_BAR; PG8_MMA(0, 0, At, B0); PG8_MMA(0, 1, At, B1); PG8_BAR; PG8_SCHED;
            PG8_LDA(At, 1, 1); PG8_STAGE(PG8_SB(1, 0), b3, voffB); PG8_STAGE(PG8_SB(1, 1), b3 + hstep, voffB); PG8_STAGE(PG8_SA(1, 0), a3, voffA);
            PG8_WAIT_V(8); PG8_WAIT_L(0); PG8_BAR; PG8_MMA(1, 0, At, B0); PG8_MMA(1, 1, At, B1); PG8_BAR; PG8_SCHED;
        }
        if (wr == 0) PG8_BAR;
        if (ui == 0) pend.wait();
        if constexpr (!Epi::AFTER_DRAIN) E(acc, cur, wr, wc, fr, fq);
        if (!has_next) break;
#pragma unroll
        for (int a = 0; a < 2; ++a)
#pragma unroll
            for (int b = 0; b < 2; ++b)
#pragma unroll
                for (int m = 0; m < 4; ++m)
#pragma unroll
                    for (int n = 0; n < 2; ++n) acc[a][b][m][n] = (f32x4){0.f, 0.f, 0.f, 0.f};
        cur = nxt; cA = nA; cB = nB; ++ui;
        if (wr == 1) PG8_BAR;
    }
    PG8_WAIT_V(0);
    PG8_BAR;
    if constexpr (Epi::AFTER_DRAIN) E.fused(acc, cur, wr, wc, fr, fq, lds, wid, lane);
#undef PG8_SA
#undef PG8_SB
#undef PG8_STAGE
#undef PG8_LDA
#undef PG8_LDB
#undef PG8_MMA
#undef PG8_WAIT_V
#undef PG8_WAIT_L
#undef PG8_BAR
#undef PG8_SCHED
}
}


#define XB_TMO      128
#define XB_XCNT(j)  (256  + 64 * (j))
#define XB_XSUB(j)  (1280 + 64 * (j))
#define XB_XGEN(j)  (2304 + 64 * (j))
#define XB_TOP      3328
#define XB_TOPGEN   3392
#define XCD_BAR_WORDS 3456
#define XB_SPIN_CAP (1u << 22)
__device__ __forceinline__ unsigned xb_ld(unsigned* p)              { return __hip_atomic_load(p, __ATOMIC_RELAXED, __HIP_MEMORY_SCOPE_AGENT); }
__device__ __forceinline__ unsigned xb_add(unsigned* p, unsigned v) { return __hip_atomic_fetch_add(p, v, __ATOMIC_RELAXED, __HIP_MEMORY_SCOPE_AGENT); }
__device__ __forceinline__ unsigned xb_xcc_id() { return (unsigned)__builtin_amdgcn_s_getreg((3 << 11) | 20) & 0xFu; }
#define XB_SPIN(cond, bar) do { unsigned _sp = 0; while (cond) { __builtin_amdgcn_s_sleep(1); \
    if ((++_sp & 255u) == 0u) { if (xb_ld(&(bar)[XB_TMO])) break; if (_sp > XB_SPIN_CAP) { atomicAdd(&(bar)[XB_TMO], 1u); break; } } } } while (0)
struct XcdBarrier { unsigned* bar; unsigned x; volatile LAS unsigned* st; };
__device__ __forceinline__ XcdBarrier xcd_barrier_post(unsigned* bar, volatile LAS unsigned* st) {
    XcdBarrier b; b.bar = bar; b.x = xb_xcc_id(); b.st = st;
    if (threadIdx.x == 0) (void)xb_add(&bar[XB_XCNT(b.x)], 1u);
    return b;
}
__device__ __forceinline__ void xcd_barrier_complete(unsigned* bar, unsigned x, unsigned& nloc, unsigned& nx) {
    const unsigned G = gridDim.x * gridDim.y * gridDim.z;
    unsigned sum, cnt, mine, sp = 0u;
    for (;;) {
        sum = 0u; cnt = 0u; mine = 0u;
#pragma unroll
        for (unsigned j = 0; j < 16; ++j) { const unsigned c = xb_ld(&bar[XB_XCNT(j)]); sum += c; cnt += (c > 0u) ? 1u : 0u; mine = (j == x) ? c : mine; }
        if (sum == G) break;
        __builtin_amdgcn_s_sleep(1);
        if ((++sp & 255u) == 0u) { if (xb_ld(&bar[XB_TMO])) break; if (sp > XB_SPIN_CAP) { atomicAdd(&bar[XB_TMO], 1u); break; } }
    }
    nloc = mine > 0u ? mine : 1u; nx = cnt > 0u ? cnt : 1u;
}
__device__ __forceinline__ void xcd_arrive(const XcdBarrier& b) {
    asm volatile("s_waitcnt vmcnt(0)" ::: "memory");
    __syncthreads();
    if (threadIdx.x == 0) {
        unsigned* bar = b.bar;
        __builtin_amdgcn_s_waitcnt(0);
        unsigned nloc = b.st[0], nx = b.st[1];
        if (nloc == 0u) { xcd_barrier_complete(bar, b.x, nloc, nx); b.st[0] = nloc; b.st[1] = nx; }
        const unsigned old = xb_add(&bar[XB_XSUB(b.x)], 1u);
        const unsigned gen = old / nloc;
        if (old + 1u == (gen + 1u) * nloc) {
            __builtin_amdgcn_fence(__ATOMIC_RELEASE, "agent");
            asm volatile("s_waitcnt vmcnt(0)" ::: "memory");
            (void)xb_add(&bar[XB_TOP], 1u);
        }
        b.st[2] = (gen + 1u) * nx;
    }
}
__device__ __forceinline__ void xcd_wait(const XcdBarrier& b) {
    if (threadIdx.x == 0) {
        unsigned* bar = b.bar; const unsigned want = b.st[2];
        XB_SPIN(xb_ld(&bar[XB_TOP]) < want, bar);
        __builtin_amdgcn_fence(__ATOMIC_ACQUIRE, "agent");
        asm volatile("s_waitcnt vmcnt(0)" ::: "memory");
    }
    __syncthreads();
}
__device__ __forceinline__ void xcd_barrier(const XcdBarrier& b) { xcd_arrive(b); xcd_wait(b); }
struct NoPend    { __device__ __forceinline__ void early() const {} __device__ __forceinline__ void wait() const {} };
struct BarPend   { const XcdBarrier* b; __device__ __forceinline__ void early() const {} __device__ __forceinline__ void wait() const { xcd_wait(*b); } };
struct EarlyPend { const XcdBarrier* b; __device__ __forceinline__ void early() const { xcd_wait(*b); } __device__ __forceinline__ void wait() const {} };
constexpr size_t WS_BAR = WS_LSE + 512 * 1024, WS_CNT0 = WS_BAR + 16384, WS_CNT1 = WS_BAR + 32768, WS_XB0 = WS_LSE + 768 * 1024, WS_XB1 = WS_WSB + 256 * 1024;
constexpr int MISC_OFF = LDS_BYTES - 128;

struct Args {
    const float* x; const float* even_norm; const float* even_w_in; const float* even_pool_w; const float* even_pool_scale; const float* even_ws; const float* even_bs;
    const float* even_w_out; const float* odd_norm; const float* odd_w_in; const float* odd_conv_w; const float* odd_w_out; const float* final_norm;
    float* out; unsigned char* ws; int ph_lo, ph_hi;
};

__device__ __forceinline__ size_t wt_off(int K, int n, int k) {
    const int nl = n & 127, x = nl & 31, rho = 16 * ((x >> 2) & 1) + 4 * (x >> 3) + (x & 3);
    const int R = (nl & ~31) + rho;
    return ((size_t)(n >> 7) * (K >> 6) + (k >> 6)) * (pg8::HTB / 2) + (size_t)(pg8::lds_byte(R, k & 63) >> 1);
}
struct TItem { const float* W; bf16_t* WT; int N, K, k0, nsrc0, ndst0; };
__device__ __forceinline__ void titem_load(const TItem& t, f32x4 (&v)[8], int lane) {
#pragma unroll
    for (int i = 0; i < 8; ++i) v[i] = *(const f32x4*)(t.W + (size_t)(t.k0 + 8 * i + (lane >> 3)) * t.N + t.nsrc0 + 4 * (lane & 7));
}
__device__ __forceinline__ void titem_finish(const TItem& t, const f32x4 (&v)[8], LAS float* scr, int lane) {
#pragma unroll
    for (int i = 0; i < 8; ++i) { LAS float* d = scr + (8 * i + (lane >> 3)) * 33 + 4 * (lane & 7); d[0] = v[i][0]; d[1] = v[i][1]; d[2] = v[i][2]; d[3] = v[i][3]; }
    asm volatile("s_waitcnt lgkmcnt(0)" ::: "memory");
    const int c = lane & 7;
#pragma unroll
    for (int j = 0; j < 4; ++j) { const int n = (lane >> 3) + 8 * j; const LAS float* sp = scr + (8 * c) * 33 + n;
        u32x4 o; o.x = cvt_pk_bf16(sp[0 * 33], sp[1 * 33]); o.y = cvt_pk_bf16(sp[2 * 33], sp[3 * 33]); o.z = cvt_pk_bf16(sp[4 * 33], sp[5 * 33]); o.w = cvt_pk_bf16(sp[6 * 33], sp[7 * 33]);
        *(u32x4*)(t.WT + wt_off(t.K, t.ndst0 + n, t.k0 + 8 * c)) = o; }
    asm volatile("s_waitcnt lgkmcnt(0)" ::: "memory");
}
__device__ __forceinline__ int w1_dst_row(int n) {
    if (n < 2048) return n;
    if (n < 3072) { const int ch = n - 2048; return 3072 + (ch / 128) * 256 + ch % 128; }
    if (n < 4096) return n - 1024;
    { const int ch = n - 4096; return 3072 + (ch / 128) * 256 + 128 + ch % 128; }
}
__device__ __forceinline__ int w3_dst_row(int n) {
    if (n < 9216) { const int which = n / 3072, rem = n % 3072, gi = rem / 1024, j = rem % 1024; return gi * 3072 + which * 1024 + j; }
    if (n < 10240) return n + 2048;
    const int rel = n - 10240, type = rel / 1024, ch = rel % 1024, t128 = ch / 128, within = ch % 128;
    if (type == 1 || type == 2) return 9216 + t128 * 256 + (type == 1 ? 0 : 128) + within;
    return 12288 + t128 * 256 + (type == 0 ? 0 : 128) + within;
}
__device__ __forceinline__ TItem w3_item(const float* W, bf16_t* W3T, int col0, int nb, int idx) { const int kb = idx / nb, nbk = idx % nb, src = col0 + nbk * 32; return TItem{W, W3T, ODD_IN, DM, kb * 64, src, w3_dst_row(src)}; }
__device__ __forceinline__ TItem wo_item(const float* W, bf16_t* WT, int idx) { const int kb = idx / 32, nbk = idx % 32; return TItem{W, WT, DM, DI, kb * 64, nbk * 32, nbk * 32}; }
__device__ __forceinline__ TItem qkv_item(const float* W, bf16_t* W3T, int gi, int r) { const int which = r / 512; return w3_item(W, W3T, which * 3072 + gi * 1024, 32, r % 512); }
template <int SEAM>
__device__ __forceinline__ void seam_convert(const float* w_out_even, const float* w_in_odd, const float* w_out_odd, bf16_t* W2T, bf16_t* W3T, bf16_t* W4T, LAS float* scr, int gw, int NGW, int lane) {
    constexpr int total = (SEAM == 1) ? 2048 : (SEAM == 2) ? 1536 : (SEAM == 3) ? 2048 : (SEAM == 4) ? 2048 : 1536;
    for (int i = gw; i < total; i += NGW) {
        TItem T;
        if (SEAM == 1) { if (i < 1024) T = wo_item(w_out_even, W2T, i); else T = qkv_item(w_in_odd, W3T, 0, i - 1024); }
        else if (SEAM == 2) { if (i < 512) T = qkv_item(w_in_odd, W3T, 0, 1024 + i); else T = wo_item(w_out_odd, W4T, i - 512); }
        else if (SEAM == 3) { if (i < 1536) T = qkv_item(w_in_odd, W3T, 1, i); else T = w3_item(w_in_odd, W3T, 11264, 64, i - 1536); }
        else if (SEAM == 4) { if (i < 1536) T = qkv_item(w_in_odd, W3T, 2, i); else T = w3_item(w_in_odd, W3T, 11264, 64, 512 + (i - 1536)); }
        else { if (i < 512) T = w3_item(w_in_odd, W3T, 9216, 32, i); else if (i < 1024) T = w3_item(w_in_odd, W3T, 10240, 32, i - 512); else T = w3_item(w_in_odd, W3T, 13312, 32, i - 1024); }
        f32x4 v[8]; titem_load(T, v, lane); titem_finish(T, v, scr, lane);
    }
}
__device__ __forceinline__ void rms_row_bf16(const float* xrow, const float* g, bf16_t* orow, int lane) {
    const f32x4* xr = (const f32x4*)xrow + lane; const f32x4* gr = (const f32x4*)g + lane;
    f32x4 v[4]; float s = 0.f;
#pragma unroll
    for (int j = 0; j < 4; ++j) { v[j] = xr[64 * j]; s += (v[j].x * v[j].x + v[j].y * v[j].y) + (v[j].z * v[j].z + v[j].w * v[j].w); }
    const float rstd = rsqrtf(wave_sum(s) * (1.f / DM) + EPS);
    u32x2* o8 = (u32x2*)orow + lane;
#pragma unroll
    for (int j = 0; j < 4; ++j) { const f32x4 gg = gr[64 * j]; u32x2 w; w.x = cvt_pk_bf16(v[j].x * rstd * gg.x, v[j].y * rstd * gg.y); w.y = cvt_pk_bf16(v[j].z * rstd * gg.z, v[j].w * rstd * gg.w); o8[64 * j] = w; }
}
__device__ __forceinline__ void rms_row2_bf16(const float* xa, const float* xb, const float* g, bf16_t* oa, bf16_t* ob, int lane) {
    const f32x4* pa = (const f32x4*)xa + lane; const f32x4* pb = (const f32x4*)xb + lane; const f32x4* gr = (const f32x4*)g + lane;
    f32x4 va[4], vb[4]; float sa = 0.f, sb = 0.f;
#pragma unroll
    for (int j = 0; j < 4; ++j) { va[j] = pa[64 * j]; vb[j] = pb[64 * j]; }
#pragma unroll
    for (int j = 0; j < 4; ++j) { sa += (va[j].x * va[j].x + va[j].y * va[j].y) + (va[j].z * va[j].z + va[j].w * va[j].w); sb += (vb[j].x * vb[j].x + vb[j].y * vb[j].y) + (vb[j].z * vb[j].z + vb[j].w * vb[j].w); }
    const float ra = rsqrtf(wave_sum(sa) * (1.f / DM) + EPS), rb = rsqrtf(wave_sum(sb) * (1.f / DM) + EPS);
    u32x2* qa = (u32x2*)oa + lane; u32x2* qb = (u32x2*)ob + lane;
#pragma unroll
    for (int j = 0; j < 4; ++j) { const f32x4 gg = gr[64 * j]; u32x2 w;
        w.x = cvt_pk_bf16(va[j].x * ra * gg.x, va[j].y * ra * gg.y); w.y = cvt_pk_bf16(va[j].z * ra * gg.z, va[j].w * ra * gg.w); qa[64 * j] = w;
        w.x = cvt_pk_bf16(vb[j].x * rb * gg.x, vb[j].y * rb * gg.y); w.y = cvt_pk_bf16(vb[j].z * rb * gg.z, vb[j].w * rb * gg.w); qb[64 * j] = w; }
}
__device__ __forceinline__ void fold_item(const float* Win, const float* PW, bf16_t* W1T, LAS float* sm, int item, int tid) {
    LAS float* As = sm;
    LAS float* Bs = sm + 64 * 33;
    const int k0 = (item >> 4) * 64, n0 = (item & 15) * 64, g = n0 >> 8, d0 = n0 & 255;
    const int tk = tid >> 4, tn = tid & 15;
    float acc[2][4];
#pragma unroll
    for (int i = 0; i < 2; ++i)
#pragma unroll
        for (int j = 0; j < 4; ++j) acc[i][j] = 0.f;
    float ra[4], rb[4];
#pragma unroll
    for (int i = 0; i < 4; ++i) { const int idx = tid + 512 * i; ra[i] = Win[(size_t)(k0 + (idx >> 5)) * EVEN_IN + g * 256 + (idx & 31)]; rb[i] = PW[((size_t)(g * 256 + (idx >> 6))) * 256 + d0 + (idx & 63)]; }
    for (int c0 = 0; c0 < 256; c0 += 32) {
        __syncthreads();
#pragma unroll
        for (int i = 0; i < 4; ++i) { const int idx = tid + 512 * i; As[(idx >> 5) * 33 + (idx & 31)] = ra[i]; Bs[(idx >> 6) * 64 + (idx & 63)] = rb[i]; }
        __syncthreads();
        if (c0 + 32 < 256) {
#pragma unroll
            for (int i = 0; i < 4; ++i) { const int idx = tid + 512 * i; ra[i] = Win[(size_t)(k0 + (idx >> 5)) * EVEN_IN + g * 256 + c0 + 32 + (idx & 31)]; rb[i] = PW[((size_t)(g * 256 + c0 + 32 + (idx >> 6))) * 256 + d0 + (idx & 63)]; }
        }
#pragma unroll 8
        for (int c = 0; c < 32; ++c) { const float a0 = As[(2 * tk) * 33 + c], a1 = As[(2 * tk + 1) * 33 + c]; const f32x4 b = *(const LAS f32x4*)(Bs + c * 64 + 4 * tn);
#pragma unroll
            for (int j = 0; j < 4; ++j) { acc[0][j] += a0 * b[j]; acc[1][j] += a1 * b[j]; } }
    }
#pragma unroll
    for (int j = 0; j < 4; ++j) *(unsigned*)(W1T + wt_off(DM, n0 + 4 * tn + j, k0 + 2 * tk)) = cvt_pk_bf16(acc[0][j], acc[1][j]);
}

__device__ __forceinline__ void unpack8(const u32x4 v, float (&f)[8]) { f[0] = bf_lo(v.x); f[1] = bf_hi(v.x); f[2] = bf_lo(v.y); f[3] = bf_hi(v.y); f[4] = bf_lo(v.z); f[5] = bf_hi(v.z); f[6] = bf_lo(v.w); f[7] = bf_hi(v.w); }
template <int W>
__device__ __forceinline__ void ya_run(const bf16_t* Z1, const float* scale, bf16_t* Y1, int t0, int oc) {
    const int tl0 = t0 & (SEQ - 1);
    constexpr int RUN = 8;
    u32x4 R[W + RUN - 1];
#pragma unroll
    for (int k = 0; k < W + RUN - 1; ++k) { const int dt = k - (W - 1); R[k] = (tl0 + dt >= 0) ? *(const u32x4*)(Z1 + (size_t)(t0 + dt) * ZP + oc * 8) : (u32x4){0u, 0u, 0u, 0u}; }
    const f32x4 sc0 = *(const f32x4*)(scale + oc * 8), sc1 = *(const f32x4*)(scale + oc * 8 + 4);
    const float sc[8] = {sc0[0], sc0[1], sc0[2], sc0[3], sc1[0], sc1[1], sc1[2], sc1[3]};
    float s[8];
#pragma unroll
    for (int e = 0; e < 8; ++e) s[e] = 0.f;
#pragma unroll
    for (int k = 0; k < W - 1; ++k) { float f[8]; unpack8(R[k], f);
#pragma unroll
        for (int e = 0; e < 8; ++e) s[e] += f[e]; }
    u32x4 GA[RUN];
#pragma unroll
    for (int i = 0; i < RUN; ++i) GA[i] = *(const u32x4*)(Z1 + (size_t)(t0 + i) * ZP + 1024 + oc * 8);
#pragma unroll
    for (int i = 0; i < RUN; ++i) {
        float cur[8]; unpack8(R[i + W - 1], cur);
#pragma unroll
        for (int e = 0; e < 8; ++e) s[e] += cur[e];
        if (i > 0) { u32x4 tmp = R[i - 1]; asm volatile("" : "+v"(tmp)); float old[8]; unpack8(tmp, old);
#pragma unroll
            for (int e = 0; e < 8; ++e) s[e] -= old[e]; }
        const int tl = tl0 + i; const float inv = 1.0f / (float)((tl + 1 < W) ? tl + 1 : W);
        float gg[8]; unpack8(GA[i], gg);
        float o[8];
#pragma unroll
        for (int e = 0; e < 8; ++e) o[e] = (s[e] * inv - cur[e]) * sc[e] * gg[e];
        u32x4 w4; w4.x = cvt_pk_bf16(o[0], o[1]); w4.y = cvt_pk_bf16(o[2], o[3]); w4.z = cvt_pk_bf16(o[4], o[5]); w4.w = cvt_pk_bf16(o[6], o[7]);
        *(u32x4*)(Y1 + (size_t)(t0 + i) * DI + oc * 8) = w4;
    }
}
__device__ __forceinline__ void ya_phase(const bf16_t* Z1, const float* scale, bf16_t* Y1, int gw, int NGW, int lane) {
    for (int it = gw; it < 4 * 1024; it += NGW) {
        const int g = it & 3, rp = it >> 2;
        const int t0 = (rp * 2 + (lane >> 5)) * 8, oc = g * 32 + (lane & 31);
        if (g == 0) ya_run<2>(Z1, scale, Y1, t0, oc); else if (g == 1) ya_run<4>(Z1, scale, Y1, t0, oc); else if (g == 2) ya_run<8>(Z1, scale, Y1, t0, oc); else ya_run<16>(Z1, scale, Y1, t0, oc);
    }
}
constexpr int VB_STRIDE = 544;
__device__ __forceinline__ void yb_phase(LAS unsigned char* lds, const bf16_t* Z1, const bf16_t* WSB, const float* bs, bf16_t* Y1, int G, int bid) {
    int tid = threadIdx.x; asm volatile("" : "+v"(tid));
    const int lane = tid & 63, w = __builtin_amdgcn_readfirstlane(tid >> 6), ql = lane & 15, gq = lane >> 4;
    for (int unit = bid; unit < 512; unit += G) {
        const int ck = unit >> 2, g = unit & 3, row0 = ck * 128;
        __syncthreads();
#pragma unroll
        for (int i = 0; i < 8; ++i) { const int idx = tid + 512 * i, rr = idx >> 5, ch = idx & 31;
            const u32x4 val = *(const u32x4*)(Z1 + (size_t)(row0 + rr) * ZP + 2048 + 256 * g + ch * 8);
            *(LAS u32x4*)(lds + rr * VB_STRIDE + ch * 16) = val; }
        __syncthreads();
        const int t = 16 * w + ql;
        bf16x8 wf[4];
#pragma unroll
        for (int ks = 0; ks < 4; ++ks) wf[ks] = *(const bf16x8*)(WSB + (size_t)(g * 128 + t) * 128 + 32 * ks + 8 * gq);
        const int nks = (w >> 1) + 1;
        const size_t rowg = (size_t)(row0 + t);
        const float bias = bs[g * 128 + t];
        const LAS unsigned char* vbase = lds + (8 * gq + (ql >> 2)) * VB_STRIDE + (ql & 3) * 8;
        u32x2 ua[16];
#pragma unroll
        for (int cb = 0; cb < 16; ++cb) { const int c0 = 256 * g + 16 * cb + 4 * gq; ua[cb] = *(const u32x2*)(Z1 + rowg * ZP + 3072 + c0); }
#pragma unroll
        for (int cb = 0; cb < 16; ++cb) {
            f32x4 acc = {0.f, 0.f, 0.f, 0.f};
#pragma unroll
            for (int ks = 0; ks < 4; ++ks) {
                if (ks < nks) {
                    const LAS unsigned char* p = vbase + ks * 32 * VB_STRIDE + cb * 32;
                    const s16x4 lo = tr_read(p), hi = tr_read(p + 4 * VB_STRIDE);
                    acc = __builtin_amdgcn_mfma_f32_16x16x32_bf16(cat8(lo, hi), wf[ks], acc, 0, 0, 0);
                }
            }
            const int c0 = 256 * g + 16 * cb + 4 * gq;
            const u32x2 u2 = ua[cb];
            const float o0 = bf_lo(u2.x) * (acc[0] + bias), o1 = bf_hi(u2.x) * (acc[1] + bias);
            const float o2 = bf_lo(u2.y) * (acc[2] + bias), o3 = bf_hi(u2.y) * (acc[3] + bias);
            u32x2 o; o.x = cvt_pk_bf16(o0, o1); o.y = cvt_pk_bf16(o2, o3);
            *(u32x2*)(Y1 + rowg * DI + 1024 + c0) = o;
        }
    }
}

constexpr int KV_STRIDE = 272, KV_BLK = 128 * KV_STRIDE, V_STRIDE = 288, V_BLK = 128 * V_STRIDE, V_BASE = 2 * KV_BLK;
template <int gi>
__device__ __forceinline__ void attn_group_phase(LAS unsigned char* lds, const bf16_t* QKV, bf16_t* O, float* LSE, int G, int bid) {
    int tid = threadIdx.x; asm volatile("" : "+v"(tid));
    const int lane = tid & 63, w = __builtin_amdgcn_readfirstlane(tid >> 6), ql = lane & 15, gq = lane >> 4;
    constexpr int dil = (gi == 0) ? 1 : (gi == 1) ? 4 : 16, nb = 64 / dil, rps = nb / 4;
    for (int job = bid; job < 256; job += G) {
        const int sub = job / rps, n0 = (job % rps) * 4;
        const int r = sub % dil, h = (sub / dil) & 7, b = sub / (dil * 8);
        const float slope = exp2f(-8.0f * (float)(gi * 8 + h + 1) / 24.0f);
        const float c1 = 0.08838834764831845f * 1.4426950408889634f, c2 = slope * (float)dil * 1.4426950408889634f;
        const size_t rowb = (size_t)b * SEQ;
        const int lrow = tid >> 4, lch = tid & 15;
        __syncthreads();
        {
            const int sp = (n0 - 1) & 1;
            LAS unsigned char* kd = lds + sp * KV_BLK; LAS unsigned char* vd = lds + V_BASE + sp * V_BLK;
            if (n0 == 0) {
#pragma unroll
                for (int ps = 0; ps < 4; ++ps) { const int rr = lrow + 32 * ps; *(LAS u32x4*)(kd + rr * KV_STRIDE + lch * 16) = (u32x4){0u, 0u, 0u, 0u}; *(LAS u32x4*)(vd + rr * V_STRIDE + lch * 16) = (u32x4){0u, 0u, 0u, 0u}; }
            } else {
                u32x4 tk[4], tv[4];
#pragma unroll
                for (int ps = 0; ps < 4; ++ps) { const int rr = lrow + 32 * ps; const size_t grow = rowb + (size_t)(128 * (n0 - 1) + rr) * dil + r;
                    const bf16_t* src = QKV + grow * 3072 + h * 128 + lch * 8; tk[ps] = *(const u32x4*)(src + 1024); tv[ps] = *(const u32x4*)(src + 2048); }
#pragma unroll
                for (int ps = 0; ps < 4; ++ps) { const int rr = lrow + 32 * ps; *(LAS u32x4*)(kd + rr * KV_STRIDE + lch * 16) = tk[ps]; *(LAS u32x4*)(vd + rr * V_STRIDE + lch * 16) = tv[ps]; }
            }
        }
        u32x4 pk[4], pv[4];
#pragma unroll
        for (int ps = 0; ps < 4; ++ps) { const int rr = lrow + 32 * ps; const size_t grow = rowb + (size_t)(128 * n0 + rr) * dil + r;
            const bf16_t* src = QKV + grow * 3072 + h * 128 + lch * 8; pk[ps] = *(const u32x4*)(src + 1024); pv[ps] = *(const u32x4*)(src + 2048); }
        for (int n = n0; n < n0 + 4; ++n) {
            const size_t growq = rowb + (size_t)(128 * n + 16 * w + ql) * dil + r;
            bf16x8 qf[4];
#pragma unroll
            for (int ks = 0; ks < 4; ++ks) qf[ks] = *(const bf16x8*)(QKV + growq * 3072 + h * 128 + 32 * ks + 8 * gq);
            {
                const int sc = n & 1;
                LAS unsigned char* kd = lds + sc * KV_BLK; LAS unsigned char* vd = lds + V_BASE + sc * V_BLK;
#pragma unroll
                for (int ps = 0; ps < 4; ++ps) { const int rr = lrow + 32 * ps; *(LAS u32x4*)(kd + rr * KV_STRIDE + lch * 16) = pk[ps]; *(LAS u32x4*)(vd + rr * V_STRIDE + lch * 16) = pv[ps]; }
            }
            __syncthreads();
            float* lsep = LSE + growq * 8 + h;
            bf16_t* op = O + growq * 1024 + h * 128 + 4 * gq;
            float lse_prev = 0.f; u32x2 oprev[8];
            if (gi > 0) { lse_prev = *lsep;
#pragma unroll
                for (int db = 0; db < 8; ++db) oprev[db] = *(const u32x2*)(op + 16 * db); }
            if (n + 1 < n0 + 4) {
#pragma unroll
                for (int ps = 0; ps < 4; ++ps) { const int rr = lrow + 32 * ps; const size_t grow = rowb + (size_t)(128 * (n + 1) + rr) * dil + r;
                    const bf16_t* src = QKV + grow * 3072 + h * 128 + lch * 8; pk[ps] = *(const u32x4*)(src + 1024); pv[ps] = *(const u32x4*)(src + 2048); }
            }
            f32x4 S[9];
#pragma unroll
            for (int kb = 0; kb < 9; ++kb) {
                const int kabs = w + kb, slot = (kabs < 8) ? ((n - 1) & 1) : (n & 1);
                const LAS unsigned char* kp = lds + slot * KV_BLK + ((kabs & 7) * 16 + ql) * KV_STRIDE + gq * 16;
                f32x4 acc = {0.f, 0.f, 0.f, 0.f};
#pragma unroll
                for (int ks = 0; ks < 4; ++ks) acc = __builtin_amdgcn_mfma_f32_16x16x32_bf16(*(const LAS bf16x8*)(kp + 64 * ks), qf[ks], acc, 0, 0, 0);
                S[kb] = acc;
            }
            float mx = -1e30f;
#pragma unroll
            for (int kb = 0; kb < 9; ++kb) {
                const bool blk_ok = (n > 0) || (w + kb >= 8);
#pragma unroll
                for (int e = 0; e < 4; ++e) {
                    const int steps = 128 + ql - 16 * kb - 4 * gq - e;
                    const bool ok = blk_ok && steps >= 0 && steps <= 128;
                    const float v = ok ? S[kb][e] * c1 - c2 * (float)steps : -1e30f;
                    S[kb][e] = v; mx = fmaxf(mx, v);
                }
            }
            mx = fmaxf(mx, __shfl_xor(mx, 16)); mx = fmaxf(mx, __shfl_xor(mx, 32));
            float l = 0.f;
#pragma unroll
            for (int kb = 0; kb < 9; ++kb)
#pragma unroll
                for (int e = 0; e < 4; ++e) { const float p = __builtin_amdgcn_exp2f(S[kb][e] - mx); S[kb][e] = p; l += p; }
            l += __shfl_xor(l, 16); l += __shfl_xor(l, 32);
            f32x4 o[8];
#pragma unroll
            for (int db = 0; db < 8; ++db) o[db] = (f32x4){0.f, 0.f, 0.f, 0.f};
#pragma unroll
            for (int p = 0; p < 5; ++p) {
                const int kx = w + 2 * p, ky = (p < 4) ? kx + 1 : kx;
                const f32x4 X = S[2 * p]; const f32x4 Yv = (p < 4) ? S[(p < 4) ? 2 * p + 1 : 0] : (f32x4){0.f, 0.f, 0.f, 0.f};
                u32x4 pw; pw.x = cvt_pk_bf16(X[0], X[1]); pw.y = cvt_pk_bf16(X[2], X[3]); pw.z = cvt_pk_bf16(Yv[0], Yv[1]); pw.w = cvt_pk_bf16(Yv[2], Yv[3]);
                const bf16x8 pf = __builtin_bit_cast(bf16x8, pw);
                const int sx = (kx < 8) ? ((n - 1) & 1) : (n & 1), sy = (ky < 8) ? ((n - 1) & 1) : (n & 1);
                const LAS unsigned char* vx = lds + V_BASE + sx * V_BLK + ((kx & 7) * 16 + 4 * gq + (ql >> 2)) * V_STRIDE + (ql & 3) * 8;
                const LAS unsigned char* vy = lds + V_BASE + sy * V_BLK + ((ky & 7) * 16 + 4 * gq + (ql >> 2)) * V_STRIDE + (ql & 3) * 8;
#pragma unroll
                for (int db = 0; db < 8; ++db) { const s16x4 lo = tr_read(vx + db * 32), hi = tr_read(vy + db * 32);
                    o[db] = __builtin_amdgcn_mfma_f32_16x16x32_bf16(cat8(lo, hi), pf, o[db], 0, 0, 0); }
            }
            const float inv_l = 1.0f / l;
            const float lse_cur = (mx + __builtin_amdgcn_logf(l)) * 0.6931471805599453f;
            float ca = 0.f, cb = inv_l, lse_new = lse_cur;
            if (gi > 0) {
                const float mm = fmaxf(lse_prev, lse_cur);
                const float wp = __expf(lse_prev - mm), wcur = __expf(lse_cur - mm), inv = 1.0f / (wp + wcur);
                ca = wp * inv; cb = wcur * inv * inv_l; lse_new = mm + __logf(wp + wcur);
            }
#pragma unroll
            for (int db = 0; db < 8; ++db) {
                f32x4 v = o[db] * cb;
                if (gi > 0) { const u32x2 pr = oprev[db]; v[0] += ca * bf_lo(pr.x); v[1] += ca * bf_hi(pr.x); v[2] += ca * bf_lo(pr.y); v[3] += ca * bf_hi(pr.y); }
                u32x2 st; st.x = cvt_pk_bf16(v[0], v[1]); st.y = cvt_pk_bf16(v[2], v[3]);
                *(u32x2*)(op + 16 * db) = st;
            }
            if (gq == 0) *lsep = lse_new;
            __syncthreads();
        }
    }
}


template <int gi>
__device__ __forceinline__ void attn_naive_phase(const bf16_t* QKV, bf16_t* O, float* LSE, int gw, int NGW, int lane) {
    constexpr int dil = (gi == 0) ? 1 : (gi == 1) ? 4 : 16;
    for (int it = gw; it < M_TOK * 8; it += NGW) {
        const int row = it >> 3, h = it & 7, tl = row & (SEQ - 1);
        const float slope = exp2f(-8.0f * (float)(gi * 8 + h + 1) / 24.0f) * (float)dil;
        const unsigned qq = *(const unsigned*)(QKV + (size_t)row * 3072 + h * 128 + 2 * lane);
        const float q0 = bf_lo(qq), q1 = bf_hi(qq);
        float m = -1e30f, l = 0.f, o0 = 0.f, o1 = 0.f;
        for (int j = 0; j <= 128; ++j) {
            if (tl - j * dil < 0) break;
            const size_t kr = (size_t)(row - j * dil) * 3072 + h * 128 + 2 * lane;
            const unsigned kk = *(const unsigned*)(QKV + kr + 1024), vv = *(const unsigned*)(QKV + kr + 2048);
            const float d = wave_sum(q0 * bf_lo(kk) + q1 * bf_hi(kk));
            const float sc = d * 0.08838834764831845f - slope * (float)j;
            const float mn = fmaxf(m, sc), f = __expf(m - mn), p = __expf(sc - mn);
            l = l * f + p; o0 = o0 * f + p * bf_lo(vv); o1 = o1 * f + p * bf_hi(vv); m = mn;
        }
        const float inv_l = 1.0f / l; const float lse_cur = m + __logf(l);
        float ca = 0.f, cb = inv_l, lse_new = lse_cur;
        float* lsep = LSE + (size_t)row * 8 + h;
        unsigned* op = (unsigned*)(O + (size_t)row * 1024 + h * 128 + 2 * lane);
        if (gi > 0) {
            const float lse_prev = *lsep; const float mm = fmaxf(lse_prev, lse_cur);
            const float wp = __expf(lse_prev - mm), wcur = __expf(lse_cur - mm), inv = 1.0f / (wp + wcur);
            ca = wp * inv; cb = wcur * inv * inv_l; lse_new = mm + __logf(wp + wcur);
            const unsigned pr = *op; o0 = o0 * cb + ca * bf_lo(pr); o1 = o1 * cb + ca * bf_hi(pr);
        } else { o0 *= cb; o1 *= cb; }
        *op = cvt_pk_bf16(o0, o1);
        if (lane == 0) *lsep = lse_new;
    }
}

__device__ __forceinline__ void conv_phase(const bf16_t* ZC, const bf16_t* GB, const float* cw, bf16_t* Y2, int gtid, int gthreads) {
    for (int it = gtid; it < (M_TOK / 8) * 128; it += gthreads) {
        const int oc = it & 127, t0 = (it >> 7) * 8, tl0 = t0 & (SEQ - 1);
        u32x4 Z[10], Gv[8];
#pragma unroll
        for (int k = 0; k < 10; ++k) Z[k] = (tl0 + k - 2 >= 0) ? *(const u32x4*)(ZC + (size_t)(t0 + k - 2) * 1024 + oc * 8) : (u32x4){0u, 0u, 0u, 0u};
#pragma unroll
        for (int k = 0; k < 8; ++k) Gv[k] = *(const u32x4*)(GB + (size_t)(t0 + k) * 1024 + oc * 8);
        float w0[8], w1[8], w2[8];
        { const f32x4 a0 = *(const f32x4*)(cw + oc * 8), a1 = *(const f32x4*)(cw + oc * 8 + 4), b0 = *(const f32x4*)(cw + 1024 + oc * 8), b1 = *(const f32x4*)(cw + 1024 + oc * 8 + 4),
                      c0 = *(const f32x4*)(cw + 2048 + oc * 8), c1 = *(const f32x4*)(cw + 2048 + oc * 8 + 4);
#pragma unroll
          for (int e = 0; e < 4; ++e) { w0[e] = a0[e]; w0[4 + e] = a1[e]; w1[e] = b0[e]; w1[4 + e] = b1[e]; w2[e] = c0[e]; w2[4 + e] = c1[e]; } }
#pragma unroll
        for (int i = 0; i < 8; ++i) {
            float z2[8], z1[8], z0[8], gg[8], o[8];
            unpack8(Z[i], z2); unpack8(Z[i + 1], z1); unpack8(Z[i + 2], z0); unpack8(Gv[i], gg);
#pragma unroll
            for (int e = 0; e < 8; ++e) o[e] = gg[e] * (w0[e] * z2[e] + w1[e] * z1[e] + w2[e] * z0[e]);
            u32x4 w4; w4.x = cvt_pk_bf16(o[0], o[1]); w4.y = cvt_pk_bf16(o[2], o[3]); w4.z = cvt_pk_bf16(o[4], o[5]); w4.w = cvt_pk_bf16(o[6], o[7]);
            *(u32x4*)(Y2 + (size_t)(t0 + i) * DI + 1024 + oc * 8) = w4;
        }
    }
}

constexpr int N_PHASES = 16;
__global__ void __launch_bounds__(512) hybrid_fwd(Args a) {
    extern __shared__ __attribute__((aligned(16))) unsigned char lds_raw[];
    LAS unsigned char* lds = (LAS unsigned char*)lds_raw;
    cg::grid_group grid = cg::this_grid();
    const int tid = threadIdx.x, lane = tid & 63, wave = __builtin_amdgcn_readfirstlane(tid >> 6);
    const int G = gridDim.x, bid = blockIdx.x;
    const int gw = bid * 8 + wave, NGW = G * 8;
    const int gtid = bid * 512 + tid, gthreads = G * 512;
    unsigned char* ws = a.ws;
    bf16_t* W1T = (bf16_t*)(ws + WS_W1T); bf16_t* W2T = (bf16_t*)(ws + WS_W2T); bf16_t* W3T = (bf16_t*)(ws + WS_W3T); bf16_t* W4T = (bf16_t*)(ws + WS_W4T);
    bf16_t* WSB = (bf16_t*)(ws + WS_WSB); float* LSE = (float*)(ws + WS_LSE);
    bf16_t* XN = (bf16_t*)(ws + WS_XN); bf16_t* X1 = (bf16_t*)(ws + WS_X1); bf16_t* Z1 = (bf16_t*)(ws + WS_Z1);
    bf16_t* QKV = (bf16_t*)(ws + WS_QKV); bf16_t* Y2 = (bf16_t*)(ws + WS_Y2); bf16_t* GBb = (bf16_t*)(ws + WS_GB);
    bf16_t* Y1 = (bf16_t*)a.out;
    bf16_t* Ob = (bf16_t*)a.out;
    bf16_t* ZC = (bf16_t*)((unsigned char*)a.out + 32 * MiB);
    const int lo = a.ph_lo, hi = a.ph_hi;
#define IN(k) (lo <= (k) && (k) < hi)
    volatile LAS unsigned* MISC = (volatile LAS unsigned*)(lds + MISC_OFF);
    if (tid < 32) MISC[tid] = 0u;
    __syncthreads();
    const XcdBarrier gbar = xcd_barrier_post((unsigned*)(ws + WS_BAR), MISC + 8);
    if (a.ph_hi > 1000) grid.sync();
#define GSYNC() xcd_barrier(gbar)
#define SYNC(k) do { if (IN(k) && IN((k) + 1)) GSYNC(); } while (0)

    if (IN(0)) {
        for (int it = bid; it < 256; it += G) fold_item(a.even_w_in, a.even_pool_w, W1T, (LAS float*)lds, it, tid);
        __syncthreads();
        LAS float* scr = (LAS float*)(lds + wave * 16384);
        constexpr int I1 = 16 * 128, I2 = 0, I3 = 0, ITOT = I1;
#define T_DECODE(it_, T_) do { int r_ = (it_); \
            if (r_ < I1) { const int kb = r_ / 128, nbk = r_ % 128; T_ = TItem{a.even_w_in, W1T, EVEN_IN, DM, kb * 64, 1024 + nbk * 32, w1_dst_row(1024 + nbk * 32)}; } \
            else if ((r_ -= I1) < I2) { const int kb = r_ / 32, nbk = r_ % 32; T_ = TItem{a.even_w_out, W2T, DM, DI, kb * 64, nbk * 32, nbk * 32}; } \
            else if ((r_ -= I2) < I3) { const int kb = r_ / 448, nbk = r_ % 448; T_ = TItem{a.odd_w_in, W3T, ODD_IN, DM, kb * 64, nbk * 32, w3_dst_row(nbk * 32)}; } \
            else { r_ -= I3; const int kb = r_ / 32, nbk = r_ % 32; T_ = TItem{a.odd_w_out, W4T, DM, DI, kb * 64, nbk * 32, nbk * 32}; } } while (0)
        if (gw < ITOT) {
            TItem cur; f32x4 vc[8]; T_DECODE(gw, cur); titem_load(cur, vc, lane);
            for (int it = gw; it < ITOT; it += NGW) {
                TItem nxt = cur; f32x4 vn[8]; const bool has = it + NGW < ITOT;
                if (has) { T_DECODE(it + NGW, nxt); titem_load(nxt, vn, lane); }
                titem_finish(cur, vc, scr, lane);
                if (has) { cur = nxt;
#pragma unroll
                    for (int i = 0; i < 8; ++i) vc[i] = vn[i]; }
            }
        }
#undef T_DECODE
        for (int i = gtid; i < 4 * 128 * 128; i += gthreads) { const int tt = (i >> 7) & 127, ss = i & 127; const float v = (ss <= tt) ? a.even_ws[i] : 0.f; WSB[i] = (bf16_t)(cvt_pk_bf16(v, 0.f) & 0xffffu); }
        for (int m = gw; m < M_TOK; m += 2 * NGW) rms_row2_bf16(a.x + (size_t)m * DM, a.x + (size_t)(m + NGW) * DM, a.even_norm, XN + (size_t)m * DM, XN + (size_t)(m + NGW) * DM, lane);
    }
    SYNC(0);
#ifdef EXP_BAR
    for (int q = 0; q < 10; ++q) GSYNC();
#endif
    if (IN(1)) { pg8::Gemm g{XN, W1T, M_TOK, EVEN_IN, DM}; pg8::StaticOrder S; S.init(M_TOK, EVEN_IN, G, bid); pg8::EpiEven E{Z1}; pg8::gemm_phase(lds, g, S, E, NoPend{}); }
    xcd_arrive(gbar); seam_convert<1>(a.even_w_out, a.odd_w_in, a.odd_w_out, W2T, W3T, W4T, (LAS float*)(lds + wave * 16384), gw, NGW, lane); xcd_wait(gbar);
    if (IN(2)) { ya_phase(Z1, a.even_pool_scale, Y1, gw, NGW, lane); yb_phase(lds, Z1, WSB, a.even_bs, Y1, G, bid); }
    xcd_arrive(gbar); seam_convert<2>(a.even_w_out, a.odd_w_in, a.odd_w_out, W2T, W3T, W4T, (LAS float*)(lds + wave * 16384), gw, NGW, lane);
    if (IN(3)) { pg8::Gemm g{Y1, W2T, M_TOK, DM, DI}; pg8::StaticOrder S; S.init(M_TOK, DM, G, bid);
        pg8::EpiResNorm<true> E{a.x, nullptr, X1, XN, nullptr, a.odd_norm, pg8::PanelSq{(float*)(ws + WS_XB0), (unsigned*)(ws + WS_CNT0)}}; pg8::gemm_phase(lds, g, S, E, EarlyPend{&gbar}); }
    xcd_arrive(gbar); seam_convert<3>(a.even_w_out, a.odd_w_in, a.odd_w_out, W2T, W3T, W4T, (LAS float*)(lds + wave * 16384), gw, NGW, lane); xcd_wait(gbar);
    if (IN(5)) { pg8::Gemm g{XN, W3T, M_TOK, 3072, DM}; pg8::StaticOrder S; S.init(M_TOK, 3072, G, bid); pg8::EpiBf16 E{QKV, 3072}; pg8::gemm_phase(lds, g, S, E, NoPend{}); }
    xcd_arrive(gbar); seam_convert<4>(a.even_w_out, a.odd_w_in, a.odd_w_out, W2T, W3T, W4T, (LAS float*)(lds + wave * 16384), gw, NGW, lane); xcd_wait(gbar);
    attn_group_phase<0>(lds, QKV, Ob, LSE, G, bid);
    xcd_arrive(gbar);
    { pg8::Gemm g{XN, W3T + (size_t)3072 * DM, M_TOK, 3072, DM}; pg8::StaticOrder S; S.init(M_TOK, 3072, G, bid); pg8::EpiBf16 E{QKV, 3072}; pg8::gemm_phase(lds, g, S, E, BarPend{&gbar}); }
    xcd_arrive(gbar); seam_convert<5>(a.even_w_out, a.odd_w_in, a.odd_w_out, W2T, W3T, W4T, (LAS float*)(lds + wave * 16384), gw, NGW, lane); xcd_wait(gbar);
    attn_group_phase<1>(lds, QKV, Ob, LSE, G, bid);
    xcd_arrive(gbar);
    { pg8::Gemm g{XN, W3T + (size_t)2 * 3072 * DM, M_TOK, 5120, DM}; pg8::StaticOrder S; S.init(M_TOK, 5120, G, bid);
        pg8::EpiQkvZc E{pg8::EpiBf16{QKV, 3072}, pg8::EpiPair{ZC, GBb}}; pg8::gemm_phase(lds, g, S, E, BarPend{&gbar}); }
    GSYNC();
    attn_group_phase<2>(lds, QKV, Ob, LSE, G, bid);
    xcd_arrive(gbar);
    { pg8::Gemm g{XN, W3T + (size_t)11264 * DM, M_TOK, 3072, DM}; pg8::StaticOrder S; S.init(M_TOK, 3072, G, bid);
        pg8::EpiGcGb E{pg8::EpiGateMul{Ob, 1024, Y2, DI}, pg8::EpiGateConv{ZC, a.odd_conv_w, Y2}}; pg8::gemm_phase(lds, g, S, E, BarPend{&gbar}); }
    xcd_arrive(gbar);
    if (IN(14)) { pg8::Gemm g{Y2, W4T, M_TOK, DM, DI}; pg8::StaticOrder S; S.init(M_TOK, DM, G, bid);
        pg8::EpiResNorm<false> E{nullptr, X1, nullptr, nullptr, a.out, a.final_norm, pg8::PanelSq{(float*)(ws + WS_XB1), (unsigned*)(ws + WS_CNT1)}}; pg8::gemm_phase(lds, g, S, E, EarlyPend{&gbar}); }
#undef IN
#undef SYNC
}

extern "C" void kernel_launch(void* const* d_in, const int* in_sizes, int n_in, void* d_out, int out_size, void* d_ws, size_t ws_size, hipStream_t stream) {
    static int grid = 0;
    if (grid == 0) {
        int dev = 0, cus = 0, per_cu = 0;
        hipGetDevice(&dev);
        hipDeviceGetAttribute(&cus, hipDeviceAttributeMultiprocessorCount, dev);
        hipFuncSetAttribute((const void*)hybrid_fwd, hipFuncAttributeMaxDynamicSharedMemorySize, LDS_BYTES);
        if (hipOccupancyMaxActiveBlocksPerMultiprocessor(&per_cu, (const void*)hybrid_fwd, 512, LDS_BYTES) != hipSuccess || per_cu < 1) per_cu = 1;
        (void)hipGetLastError();
        grid = cus * per_cu;
        if (grid <= 0) grid = 256;
    }
    Args a{};
    a.x = (const float*)d_in[0]; a.even_norm = (const float*)d_in[1]; a.even_w_in = (const float*)d_in[2]; a.even_pool_w = (const float*)d_in[3];
    a.even_pool_scale = (const float*)d_in[4]; a.even_ws = (const float*)d_in[5]; a.even_bs = (const float*)d_in[6]; a.even_w_out = (const float*)d_in[7];
    a.odd_norm = (const float*)d_in[8]; a.odd_w_in = (const float*)d_in[9]; a.odd_conv_w = (const float*)d_in[10]; a.odd_w_out = (const float*)d_in[11];
    a.final_norm = (const float*)d_in[12];
    a.out = (float*)d_out; a.ws = (unsigned char*)d_ws; a.ph_lo = 0; a.ph_hi = N_PHASES;
    (void)hipMemsetAsync((char*)d_ws + WS_BAR, 0, 49152, stream);
    void* args[] = {&a};
    hipError_t e = hipLaunchCooperativeKernel((const void*)hybrid_fwd, dim3(grid), dim3(512), args, LDS_BYTES, stream);
    if (e != hipSuccess) fprintf(stderr, "cooperative launch failed: %s (grid %d)\n", hipGetErrorString(e), grid);
}
```

```cpp
#define NAIVE_ATTN 0

#include <hip/hip_runtime.h>
#include <hip/hip_cooperative_groups.h>
#include <cstdio>
#include <cstdint>
namespace cg = cooperative_groups;

#define LAS __attribute__((address_space(3)))
typedef unsigned short bf16_t;
typedef short bf16x8 __attribute__((ext_vector_type(8)));
typedef short s16x4 __attribute__((ext_vector_type(4)));
typedef float f32x4 __attribute__((ext_vector_type(4)));
typedef float f32x2 __attribute__((ext_vector_type(2)));
typedef unsigned u32x4 __attribute__((ext_vector_type(4)));
typedef unsigned u32x2 __attribute__((ext_vector_type(2)));

constexpr int M_TOK = 16384, SEQ = 8192, DM = 1024;
constexpr int EVEN_IN = 5120, ODD_IN = 14336, DI = 2048, ZP = 4096;
constexpr float EPS = 1e-6f;
constexpr size_t MiB = 1u << 20;
constexpr size_t WS_W1T = 0, WS_W2T = 10 * MiB, WS_W3T = 14 * MiB, WS_W4T = 42 * MiB, WS_WSB = 46 * MiB, WS_LSE = 47 * MiB;
constexpr size_t WS_XN = 48 * MiB, WS_X1 = 80 * MiB, WS_Z1 = 80 * MiB, WS_QKV = 144 * MiB, WS_Y2 = 144 * MiB, WS_GB = 208 * MiB;
constexpr int LDS_BYTES = 147456;

typedef __bf16 bf16x2_t __attribute__((ext_vector_type(2)));
__device__ __forceinline__ unsigned cvt_pk_bf16(float lo, float hi) { f32x2 v = {lo, hi}; bf16x2_t b = __builtin_convertvector(v, bf16x2_t); return __builtin_bit_cast(unsigned, b); }
__device__ __forceinline__ float bf_lo(unsigned u) { return __uint_as_float(u << 16); }
__device__ __forceinline__ float bf_hi(unsigned u) { return __uint_as_float(u & 0xffff0000u); }
__device__ __forceinline__ float silu_f(float x) { return x * __builtin_amdgcn_rcpf(1.0f + __expf(-x)); }
__device__ __forceinline__ float wave_sum(float v) {
#pragma unroll
    for (int o = 1; o < 64; o <<= 1) v += __shfl_xor(v, o);
    return v;
}
__device__ __forceinline__ s16x4 tr_read(const LAS unsigned char* p) {
    typedef short v4i16_t __attribute__((ext_vector_type(4)));
    return __builtin_bit_cast(s16x4, __builtin_amdgcn_ds_read_tr16_b64_v4i16((LAS v4i16_t*)p));
}
__device__ __forceinline__ bf16x8 cat8(s16x4 lo, s16x4 hi) { return (bf16x8){lo[0], lo[1], lo[2], lo[3], hi[0], hi[1], hi[2], hi[3]}; }

namespace pg8 {
constexpr int BM = 256, BK = 64, HALF = 128, HTB = HALF * BK * 2, STAGE_BYTES = 8 * HTB, NXCD = 8, WGM = 8;
__host__ __device__ __forceinline__ int lds_byte(int r, int c) { const int st = (r >> 4) * 2 + (c >> 5), rr = r & 15, cc = c & 31, ob = rr * 64 + cc * 2; return st * 1024 + (ob ^ (((ob >> 9) & 1) << 5)); }
__host__ __device__ __forceinline__ void stage_rc(int b, int& R, int& C) { const int st = b / 1024, sb = b % 1024, swz = sb ^ (((sb >> 9) & 1) << 5); R = (st >> 1) * 16 + swz / 64; C = (st & 1) * 32 + (swz % 64) / 2; }
__host__ __device__ __forceinline__ int perm32(int rho) { const int n = rho >> 4, i = rho & 15; return 8 * (i >> 2) + 4 * n + (i & 3); }

__host__ __device__ __forceinline__ size_t a_off(int K, int m, int k) { return ((size_t)(m >> 7) * (K >> 6) + (k >> 6)) * (HTB / 2) + (size_t)(lds_byte(m & 127, k & 63) >> 1); }
struct Unit { int pm, pn; };
struct Gemm { const bf16_t* A; const bf16_t* Bt; int M, N, K; };

struct StaticOrder {
    int nM, nN, nwg, G, c;
    __host__ __device__ void init(int M, int N, int G_, int c_) { nM = M / BM; nN = N / BM; nwg = nM * nN; G = G_; c = c_; }
    __host__ __device__ bool next(int i, Unit& u) const {
        const long L = (long)i * G + c; if (L >= nwg) return false;
        int wgid = (int)L; { const int q = nwg / NXCD, r = nwg % NXCD, xcd = wgid % NXCD, off = wgid / NXCD; wgid = (xcd < r ? xcd * (q + 1) : r * (q + 1) + (xcd - r) * q) + off; }
        const int nig = WGM * nN, gid = wgid / nig, fm = gid * WGM, gsz = (nM - fm) < WGM ? (nM - fm) : WGM;
        u.pm = fm + ((wgid % nig) % gsz); u.pn = (wgid % nig) / gsz; return true;
    }
};

struct EpiBf16 {
    static constexpr bool AFTER_DRAIN = false; static constexpr bool HAS_INIT = false;
    static constexpr bool PERM = true;
    bf16_t* O; int ldc;
    __device__ __forceinline__ void operator()(const f32x4 (&acc)[2][2][4][2], const Unit& u, int wr, int wc, int fr, int fq) const {
        const int row0 = u.pm * BM + wr * 64 + fr; const int col0 = u.pn * BM + wc * 32 + 8 * fq;
#pragma unroll
        for (int ai = 0; ai < 2; ++ai)
#pragma unroll
            for (int m = 0; m < 4; ++m) { bf16_t* rowp = O + (size_t)(row0 + ai * HALF + m * 16) * ldc + col0;
#pragma unroll
                for (int bj = 0; bj < 2; ++bj) { const f32x4 v0 = acc[ai][bj][m][0], v1 = acc[ai][bj][m][1];
                    u32x4 w; w.x = cvt_pk_bf16(v0[0], v0[1]); w.y = cvt_pk_bf16(v0[2], v0[3]); w.z = cvt_pk_bf16(v1[0], v1[1]); w.w = cvt_pk_bf16(v1[2], v1[3]);
                    *(u32x4*)(rowp + bj * HALF) = w; } }
    }
};
struct EpiResF32 {
    static constexpr bool AFTER_DRAIN = false; static constexpr bool HAS_INIT = false;
    static constexpr bool PERM = false;
    const float* base; float* out; int ldc;
    __device__ __forceinline__ void operator()(const f32x4 (&acc)[2][2][4][2], const Unit& u, int wr, int wc, int fr, int fq) const {
        const int col0 = u.pn * BM + wc * 32 + 4 * fq;
#pragma unroll
        for (int ai = 0; ai < 2; ++ai)
#pragma unroll
            for (int m = 0; m < 4; ++m) { const size_t off = (size_t)(u.pm * BM + ai * HALF + wr * 64 + m * 16 + fr) * ldc + col0;
#pragma unroll
                for (int bj = 0; bj < 2; ++bj)
#pragma unroll
                    for (int n = 0; n < 2; ++n) { const f32x4 bs = *(const f32x4*)(base + off + bj * HALF + n * 16); *(f32x4*)(out + off + bj * HALF + n * 16) = bs + acc[ai][bj][m][n]; } }
    }
};
struct EpiGateMul {
    static constexpr bool AFTER_DRAIN = false; static constexpr bool HAS_INIT = false;
    static constexpr bool PERM = true;
    const bf16_t* Oin; int ldo; bf16_t* Y; int ldy;
    __device__ __forceinline__ void operator()(const f32x4 (&acc)[2][2][4][2], const Unit& u, int wr, int wc, int fr, int fq) const {
        const int row0 = u.pm * BM + wr * 64 + fr; const int col0 = u.pn * BM + wc * 32 + 8 * fq;
#pragma unroll
        for (int ai = 0; ai < 2; ++ai)
#pragma unroll
            for (int m = 0; m < 4; ++m) { const size_t row = (size_t)(row0 + ai * HALF + m * 16);
#pragma unroll
                for (int bj = 0; bj < 2; ++bj) { const f32x4 v0 = acc[ai][bj][m][0], v1 = acc[ai][bj][m][1];
                    const u32x4 o = *(const u32x4*)(Oin + row * ldo + col0 + bj * HALF);
                    u32x4 w;
                    w.x = cvt_pk_bf16(bf_lo(o.x) * silu_f(v0[0]), bf_hi(o.x) * silu_f(v0[1])); w.y = cvt_pk_bf16(bf_lo(o.y) * silu_f(v0[2]), bf_hi(o.y) * silu_f(v0[3]));
                    w.z = cvt_pk_bf16(bf_lo(o.z) * silu_f(v1[0]), bf_hi(o.z) * silu_f(v1[1])); w.w = cvt_pk_bf16(bf_lo(o.w) * silu_f(v1[2]), bf_hi(o.w) * silu_f(v1[3]));
                    *(u32x4*)(Y + a_off(ldy, (int)row, col0 + bj * HALF)) = w; } }
    }
};
struct EpiPair {
    static constexpr bool AFTER_DRAIN = false; static constexpr bool HAS_INIT = false;
    static constexpr bool PERM = true;
    bf16_t* ZC; bf16_t* GB;
    __device__ __forceinline__ void operator()(const f32x4 (&acc)[2][2][4][2], const Unit& u, int wr, int wc, int fr, int fq) const {
        const int row0 = u.pm * BM + wr * 64 + fr; const bool gate = u.pn >= 8; const int ct = gate ? u.pn - 8 : u.pn;
        bf16_t* dst = (gate ? GB : ZC) + ct * 128 + wc * 32 + 8 * fq;
#pragma unroll
        for (int ai = 0; ai < 2; ++ai)
#pragma unroll
            for (int m = 0; m < 4; ++m) { const size_t row = (size_t)(row0 + ai * HALF + m * 16);
                f32x4 p0 = acc[ai][0][m][0], p1 = acc[ai][0][m][1], q0 = acc[ai][1][m][0], q1 = acc[ai][1][m][1];
                if (gate) {
#pragma unroll
                    for (int e = 0; e < 4; ++e) { q0[e] = silu_f(q0[e]); q1[e] = silu_f(q1[e]); } }
                p0 = p0 * q0; p1 = p1 * q1;
                u32x4 w; w.x = cvt_pk_bf16(p0[0], p0[1]); w.y = cvt_pk_bf16(p0[2], p0[3]); w.z = cvt_pk_bf16(p1[0], p1[1]); w.w = cvt_pk_bf16(p1[2], p1[3]);
                *(u32x4*)(dst + row * 1024) = w; }
    }
};


struct EpiGateConv {
    static constexpr bool AFTER_DRAIN = false; static constexpr bool HAS_INIT = false;
    static constexpr bool PERM = true;
    const bf16_t* ZC; const float* cw; bf16_t* Y2;
    __device__ __forceinline__ void operator()(const f32x4 (&acc)[2][2][4][2], const Unit& u, int wr, int wc, int fr, int fq) const {
        const int row0 = u.pm * BM + wr * 64 + fr; const int ch0 = u.pn * 128 + wc * 32 + 8 * fq;
        const f32x4 wa0 = *(const f32x4*)(cw + ch0), wa1 = *(const f32x4*)(cw + ch0 + 4), wb0 = *(const f32x4*)(cw + 1024 + ch0), wb1 = *(const f32x4*)(cw + 1024 + ch0 + 4),
                    wc0 = *(const f32x4*)(cw + 2048 + ch0), wc1 = *(const f32x4*)(cw + 2048 + ch0 + 4);
#pragma unroll
        for (int ai = 0; ai < 2; ++ai)
#pragma unroll
            for (int m = 0; m < 4; ++m) { const int row = row0 + ai * HALF + m * 16; const int tl = row & (SEQ - 1);
                const bf16_t* zp = ZC + (size_t)row * 1024 + ch0;
                const u32x4 z0 = *(const u32x4*)zp;
                const u32x4 z1 = (tl >= 1) ? *(const u32x4*)(zp - 1024) : (u32x4){0u, 0u, 0u, 0u};
                const u32x4 z2 = (tl >= 2) ? *(const u32x4*)(zp - 2048) : (u32x4){0u, 0u, 0u, 0u};
                f32x4 p0 = acc[ai][0][m][0], p1 = acc[ai][0][m][1]; const f32x4 q0 = acc[ai][1][m][0], q1 = acc[ai][1][m][1];
#pragma unroll
                for (int e = 0; e < 4; ++e) { p0[e] *= silu_f(q0[e]); p1[e] *= silu_f(q1[e]); }
                const f32x4 a0 = {bf_lo(z0.x), bf_hi(z0.x), bf_lo(z0.y), bf_hi(z0.y)}, a1 = {bf_lo(z0.z), bf_hi(z0.z), bf_lo(z0.w), bf_hi(z0.w)};
                const f32x4 b0 = {bf_lo(z1.x), bf_hi(z1.x), bf_lo(z1.y), bf_hi(z1.y)}, b1 = {bf_lo(z1.z), bf_hi(z1.z), bf_lo(z1.w), bf_hi(z1.w)};
                const f32x4 c0 = {bf_lo(z2.x), bf_hi(z2.x), bf_lo(z2.y), bf_hi(z2.y)}, c1 = {bf_lo(z2.z), bf_hi(z2.z), bf_lo(z2.w), bf_hi(z2.w)};
                p0 = p0 * (wa0 * c0 + wb0 * b0 + wc0 * a0); p1 = p1 * (wa1 * c1 + wb1 * b1 + wc1 * a1);
                u32x4 w; w.x = cvt_pk_bf16(p0[0], p0[1]); w.y = cvt_pk_bf16(p0[2], p0[3]); w.z = cvt_pk_bf16(p1[0], p1[1]); w.w = cvt_pk_bf16(p1[2], p1[3]);
                *(u32x4*)(Y2 + a_off(DI, row, 1024 + ch0)) = w; }
    }
};

struct EpiQkvZc {
    static constexpr bool AFTER_DRAIN = false, PERM = true, HAS_INIT = false;
    EpiBf16 e0; EpiPair e1;
    __device__ __forceinline__ void operator()(const f32x4 (&acc)[2][2][4][2], const Unit& u, int wr, int wc, int fr, int fq) const {
        if (u.pn < 12) e0(acc, u, wr, wc, fr, fq); else { Unit v = u; v.pn -= 12; e1(acc, v, wr, wc, fr, fq); }
    }
};
struct EpiGcGb {
    static constexpr bool AFTER_DRAIN = false, PERM = true, HAS_INIT = false;
    EpiGateMul e0; EpiGateConv e1;
    __device__ __forceinline__ void operator()(const f32x4 (&acc)[2][2][4][2], const Unit& u, int wr, int wc, int fr, int fq) const {
        if (u.pn < 4) e0(acc, u, wr, wc, fr, fq); else { Unit v = u; v.pn -= 4; e1(acc, v, wr, wc, fr, fq); }
    }
};

struct EpiEven {
    static constexpr bool AFTER_DRAIN = false, PERM = true, HAS_INIT = false;
    bf16_t* Z;
    __device__ __forceinline__ void operator()(const f32x4 (&acc)[2][2][4][2], const Unit& u, int wr, int wc, int fr, int fq) const {
        const int row0 = u.pm * BM + wr * 64 + fr;
        if (u.pn < 12) {
            const bool act = (u.pn >= 4) && (u.pn < 8); const int col0 = u.pn * BM + wc * 32 + 8 * fq;
#pragma unroll
            for (int ai = 0; ai < 2; ++ai)
#pragma unroll
                for (int m = 0; m < 4; ++m) { bf16_t* rowp = Z + (size_t)(row0 + ai * HALF + m * 16) * ZP + col0;
#pragma unroll
                    for (int bj = 0; bj < 2; ++bj) { f32x4 v0 = acc[ai][bj][m][0], v1 = acc[ai][bj][m][1];
                        if (act) {
#pragma unroll
                            for (int e = 0; e < 4; ++e) { v0[e] = silu_f(v0[e]); v1[e] = silu_f(v1[e]); } }
                        u32x4 w; w.x = cvt_pk_bf16(v0[0], v0[1]); w.y = cvt_pk_bf16(v0[2], v0[3]); w.z = cvt_pk_bf16(v1[0], v1[1]); w.w = cvt_pk_bf16(v1[2], v1[3]);
                        *(u32x4*)(rowp + bj * HALF) = w; } }
        } else {
            bf16_t* dst = Z + 3072 + (u.pn - 12) * 128 + wc * 32 + 8 * fq;
#pragma unroll
            for (int ai = 0; ai < 2; ++ai)
#pragma unroll
                for (int m = 0; m < 4; ++m) { const size_t row = (size_t)(row0 + ai * HALF + m * 16);
                    f32x4 p0 = acc[ai][0][m][0], p1 = acc[ai][0][m][1]; const f32x4 q0 = acc[ai][1][m][0], q1 = acc[ai][1][m][1];
#pragma unroll
                    for (int e = 0; e < 4; ++e) { p0[e] *= silu_f(q0[e]); p1[e] *= silu_f(q1[e]); }
                    u32x4 w; w.x = cvt_pk_bf16(p0[0], p0[1]); w.y = cvt_pk_bf16(p0[2], p0[3]); w.z = cvt_pk_bf16(p1[0], p1[1]); w.w = cvt_pk_bf16(p1[2], p1[3]);
                    *(u32x4*)(dst + row * ZP) = w; }
        }
    }
};

struct PanelSq {
    float* xbuf;
    unsigned* cnt;
    __device__ __forceinline__ void run(const f32x4 (&v)[2][2][4][2], const Unit& u, int wr, int wc, int fr, int fq, LAS unsigned char* lds, int wid, int lane) const {
        LAS float* P = (LAS float*)lds;
        LAS float* S = (LAS float*)(lds + 4096);
#pragma unroll
        for (int ai = 0; ai < 2; ++ai)
#pragma unroll
            for (int m = 0; m < 4; ++m) {
                float q = 0.f;
#pragma unroll
                for (int bj = 0; bj < 2; ++bj)
#pragma unroll
                    for (int n = 0; n < 2; ++n) { const f32x4 x = v[ai][bj][m][n]; q += (x[0] * x[0] + x[1] * x[1]) + (x[2] * x[2] + x[3] * x[3]); }
                q += __shfl_xor(q, 16); q += __shfl_xor(q, 32);
                if (fq == 0) P[(ai * HALF + wr * 64 + m * 16 + fr) * 4 + wc] = q;
            }
        asm volatile("s_waitcnt lgkmcnt(0)" ::: "memory"); __builtin_amdgcn_s_barrier(); asm volatile("" ::: "memory");
        const int row = wid * 64 + lane;
        if (wid < 4) {
            const float tot = (P[row * 4 + 0] + P[row * 4 + 1]) + (P[row * 4 + 2] + P[row * 4 + 3]);
            __hip_atomic_store(xbuf + (size_t)(u.pm * BM + row) * 4 + u.pn, tot, __ATOMIC_RELAXED, __HIP_MEMORY_SCOPE_AGENT);
        }
        asm volatile("s_waitcnt vmcnt(0)" ::: "memory");
        if (wid < 4 && lane == 0) __hip_atomic_fetch_add(cnt + 64 * u.pm, 1u, __ATOMIC_RELAXED, __HIP_MEMORY_SCOPE_AGENT);
        if (wid == 0) {
            unsigned sp = 0;
            while ((unsigned)__builtin_amdgcn_readfirstlane(__hip_atomic_load(cnt + 64 * u.pm, __ATOMIC_RELAXED, __HIP_MEMORY_SCOPE_AGENT)) < 16u) { __builtin_amdgcn_s_sleep(2); if (++sp > (1u << 22)) break; }
            __builtin_amdgcn_fence(__ATOMIC_ACQUIRE, "agent");
        }
        asm volatile("s_waitcnt vmcnt(0) lgkmcnt(0)" ::: "memory"); __builtin_amdgcn_s_barrier(); asm volatile("" ::: "memory");
        if (wid < 4) {
            const float* slot = xbuf + (size_t)(u.pm * BM + row) * 4;
            const float a0 = __hip_atomic_load(slot + 0, __ATOMIC_RELAXED, __HIP_MEMORY_SCOPE_AGENT), a1 = __hip_atomic_load(slot + 1, __ATOMIC_RELAXED, __HIP_MEMORY_SCOPE_AGENT);
            const float a2 = __hip_atomic_load(slot + 2, __ATOMIC_RELAXED, __HIP_MEMORY_SCOPE_AGENT), a3 = __hip_atomic_load(slot + 3, __ATOMIC_RELAXED, __HIP_MEMORY_SCOPE_AGENT);
            S[row] = rsqrtf(((a0 + a1) + (a2 + a3)) * (1.f / 1024.f) + 1e-6f);
        }
        asm volatile("s_waitcnt lgkmcnt(0)" ::: "memory"); __builtin_amdgcn_s_barrier(); asm volatile("" ::: "memory");
    }
};
template <bool WRITE_X  >
struct EpiResNorm {
    static constexpr bool PERM = true, AFTER_DRAIN = true, HAS_INIT = true; static constexpr int NSTORES = 0;
    const float* base; const bf16_t* base16; bf16_t* xout; bf16_t* xn; float* nout; const float* g; PanelSq st;
    __device__ __forceinline__ void init(f32x4 (&acc)[2][2][4][2], const Unit& u, int wr, int wc, int fr, int fq) const {
        const int col0 = u.pn * BM + wc * 32 + 8 * fq;
#pragma unroll
        for (int ai = 0; ai < 2; ++ai)
#pragma unroll
            for (int m = 0; m < 4; ++m) { const size_t off = (size_t)(u.pm * BM + ai * HALF + wr * 64 + m * 16 + fr) * 1024 + col0;
#pragma unroll
                for (int bj = 0; bj < 2; ++bj) {
                    if (WRITE_X) { acc[ai][bj][m][0] = *(const f32x4*)(base + off + bj * HALF); acc[ai][bj][m][1] = *(const f32x4*)(base + off + bj * HALF + 4); }
                    else { const u32x4 b4 = *(const u32x4*)(base16 + off + bj * HALF);
                        acc[ai][bj][m][0] = (f32x4){bf_lo(b4.x), bf_hi(b4.x), bf_lo(b4.y), bf_hi(b4.y)}; acc[ai][bj][m][1] = (f32x4){bf_lo(b4.z), bf_hi(b4.z), bf_lo(b4.w), bf_hi(b4.w)}; } } }
    }
    __device__ __forceinline__ void fused(f32x4 (&acc)[2][2][4][2], const Unit& u, int wr, int wc, int fr, int fq, LAS unsigned char* lds, int wid, int lane) const {
        const int col0 = u.pn * BM + wc * 32 + 8 * fq;
        st.run(acc, u, wr, wc, fr, fq, lds, wid, lane);
        const LAS float* S = (const LAS float*)(lds + 4096);
        f32x4 gv[2][2];
#pragma unroll
        for (int bj = 0; bj < 2; ++bj)
#pragma unroll
            for (int n = 0; n < 2; ++n) gv[bj][n] = *(const f32x4*)(g + col0 + bj * HALF + n * 4);
#pragma unroll
        for (int ai = 0; ai < 2; ++ai)
#pragma unroll
            for (int m = 0; m < 4; ++m) { const int r = ai * HALF + wr * 64 + m * 16 + fr; const float rstd = S[r]; const size_t off = (size_t)(u.pm * BM + r) * 1024 + col0;
#pragma unroll
                for (int bj = 0; bj < 2; ++bj) { const f32x4 x0 = acc[ai][bj][m][0], x1 = acc[ai][bj][m][1]; const f32x4 y0 = x0 * rstd * gv[bj][0], y1 = x1 * rstd * gv[bj][1];
                    if (WRITE_X) { u32x4 xw; xw.x = cvt_pk_bf16(x0[0], x0[1]); xw.y = cvt_pk_bf16(x0[2], x0[3]); xw.z = cvt_pk_bf16(x1[0], x1[1]); xw.w = cvt_pk_bf16(x1[2], x1[3]); *(u32x4*)(xout + off + bj * HALF) = xw;
                        u32x4 w; w.x = cvt_pk_bf16(y0[0], y0[1]); w.y = cvt_pk_bf16(y0[2], y0[3]); w.z = cvt_pk_bf16(y1[0], y1[1]); w.w = cvt_pk_bf16(y1[2], y1[3]); *(u32x4*)(xn + a_off(1024, u.pm * BM + r, col0 + bj * HALF)) = w; }
                    else { *(f32x4*)(nout + off + bj * HALF) = y0; *(f32x4*)(nout + off + bj * HALF + 4) = y1; } } }
    }
};

template <class Epi, class Sched, class Pend>
__device__ __forceinline__ void gemm_phase(LAS unsigned char* lds, const Gemm g, const Sched& S, const Epi& E, const Pend& pend) {
    int tid = threadIdx.x; asm volatile("" : "+v"(tid));
    const int wid = __builtin_amdgcn_readfirstlane(tid >> 6), lane = tid & 63, wr = wid >> 2, wc = wid & 3, fr = lane & 15, fq = lane >> 4;
    const int K = g.K, nt = K / BK;
    unsigned voffA[2], voffB[2];
#pragma unroll
    for (int i = 0; i < 2; ++i) { int R, C; stage_rc(tid * 16 + i * 8192, R, C); const int Rb = Epi::PERM ? ((R & ~31) + perm32(R & 31)) : R;
        voffA[i] = (unsigned)(tid * 16 + i * 8192); voffB[i] = (unsigned)(tid * 16 + i * 8192); (void)Rb; (void)R; (void)C; }
    const size_t kstep = (size_t)HTB;
    const size_t kstepB = (size_t)HTB;
    const size_t hstep = (size_t)HALF * K * 2;
    const size_t tstep = 2 * hstep;
    const unsigned ldsw = (unsigned)wid * 1024u;
    const int aoff = lds_byte(wr * 64 + fr, fq * 8), boff = lds_byte(wc * 32 + fr, fq * 8);
#define PG8_SA(b, h) (((b) * 2 + (h)) * HTB)
#define PG8_SB(b, h) ((4 + (b) * 2 + (h)) * HTB)
#define PG8_STAGE(bufoff, gbase, voff) do { _Pragma("unroll") for (int _i = 0; _i < 2; ++_i) \
        __builtin_amdgcn_global_load_lds((const unsigned*)((const char*)(gbase) + (voff)[_i]), (LAS unsigned*)(lds + (bufoff) + ldsw + _i * 8192), 16, 0, 0); } while (0)
#define PG8_LDA(dst, b, h) do { _Pragma("unroll") for (int m = 0; m < 4; ++m) _Pragma("unroll") for (int k = 0; k < 2; ++k) dst[m][k] = *(const LAS bf16x8*)(lds + PG8_SA(b, h) + aoff + m * 2048 + k * 1024); } while (0)
#define PG8_LDB(dst, b, h) do { _Pragma("unroll") for (int n = 0; n < 2; ++n) _Pragma("unroll") for (int k = 0; k < 2; ++k) dst[n][k] = *(const LAS bf16x8*)(lds + PG8_SB(b, h) + boff + n * 2048 + k * 1024); } while (0)
#define PG8_MMA(ai, bj, At, Bt) do { __builtin_amdgcn_s_setprio(1); _Pragma("unroll") for (int m = 0; m < 4; ++m) _Pragma("unroll") for (int n = 0; n < 2; ++n) _Pragma("unroll") for (int k = 0; k < 2; ++k) \
        acc[ai][bj][m][n] = __builtin_amdgcn_mfma_f32_16x16x32_bf16(Bt[n][k], At[m][k], acc[ai][bj][m][n], 0, 0, 0); __builtin_amdgcn_s_setprio(0); } while (0)
#define PG8_WAIT_V(n) asm volatile("s_waitcnt vmcnt(" #n ")" ::: "memory")
#define PG8_WAIT_L(n) asm volatile("s_waitcnt lgkmcnt(" #n ")" ::: "memory")
#define PG8_BAR __builtin_amdgcn_s_barrier()
#define PG8_SCHED __builtin_amdgcn_sched_barrier(0)
    Unit cur, nxt; int ui = 0;
    if (!S.next(0, cur)) return;
    f32x4 acc[2][2][4][2];
    if constexpr (Epi::HAS_INIT) E.init(acc, cur, wr, wc, fr, fq);
    else {
#pragma unroll
        for (int a = 0; a < 2; ++a)
#pragma unroll
            for (int b = 0; b < 2; ++b)
#pragma unroll
                for (int m = 0; m < 4; ++m)
#pragma unroll
                    for (int n = 0; n < 2; ++n) acc[a][b][m][n] = (f32x4){0.f, 0.f, 0.f, 0.f};
    }
    pend.early();
    bf16x8 At[4][2], B0[2][2], B1[2][2];
    const char* cA = (const char*)g.A + (size_t)cur.pm * tstep; const char* cB = (const char*)g.Bt + (size_t)cur.pn * tstep;
    PG8_STAGE(PG8_SB(0, 0), cB, voffB); PG8_STAGE(PG8_SB(0, 1), cB + hstep, voffB); PG8_STAGE(PG8_SA(0, 0), cA, voffA); PG8_STAGE(PG8_SA(0, 1), cA + hstep, voffA);
    if (wr == 1) PG8_BAR;
    PG8_WAIT_V(2); PG8_BAR;
    PG8_STAGE(PG8_SB(1, 0), cB + kstepB, voffB); PG8_STAGE(PG8_SA(1, 0), cA + kstep, voffA); PG8_STAGE(PG8_SB(1, 1), cB + hstep + kstepB, voffB);
    PG8_WAIT_V(6); PG8_BAR;
    for (;;) {
        const bool has_next = S.next(ui + 1, nxt);
        const char* nA = has_next ? (const char*)g.A + (size_t)nxt.pm * tstep : cA; const char* nB = has_next ? (const char*)g.Bt + (size_t)nxt.pn * tstep : cB;
        for (int t = 0; t < nt; t += 2) {
            const bool last = (t == nt - 2);
            const char* a1 = cA + (size_t)(t + 1) * kstep;
            const char* a2 = last ? nA : cA + (size_t)(t + 2) * kstep; const char* b2 = last ? nB : cB + (size_t)(t + 2) * kstepB;
            const char* a3 = a2 + kstep; const char* b3 = b2 + kstepB;
            PG8_LDB(B0, 0, 0); PG8_LDB(B1, 0, 1); PG8_SCHED; PG8_LDA(At, 0, 0); PG8_STAGE(PG8_SA(1, 1), a1 + hstep, voffA);
            PG8_WAIT_V(8); PG8_WAIT_L(0); PG8_BAR; PG8_MMA(0, 0, At, B0); PG8_MMA(0, 1, At, B1); PG8_BAR; PG8_SCHED;
            PG8_LDA(At, 0, 1); PG8_STAGE(PG8_SB(0, 0), b2, voffB); PG8_STAGE(PG8_SB(0, 1), b2 + hstep, voffB); PG8_STAGE(PG8_SA(0, 0), a2, voffA);
            PG8_WAIT_V(8); PG8_WAIT_L(0); PG8_BAR; PG8_MMA(1, 0, At, B0); PG8_MMA(1, 1, At, B1); PG8_BAR; PG8_SCHED;
            PG8_LDB(B0, 1, 0); PG8_LDB(B1, 1, 1); PG8_SCHED; PG8_LDA(At, 1, 0); PG8_STAGE(PG8_SA(0, 1), a2 + hstep, voffA);
            PG8_WAIT_V(8); PG8_WAIT_L(0); PG8_BAR; PG8_MMA(0, 0, At, B0); PG8_MMA(0, 1, At, B1); PG8_BAR; PG8_SCHED;
            PG8_LDA(At, 1, 1); PG8_STAGE(PG8_SB(1, 0), b3, voffB); PG8_STAGE(PG8_SB(1, 1), b3 + hstep, voffB); PG8_STAGE(PG8_SA(1, 0), a3, voffA);
            PG8_WAIT_V(8); PG8_WAIT_L(0); PG8_BAR; PG8_MMA(1, 0, At, B0); PG8_MMA(1, 1, At, B1); PG8_BAR; PG8_SCHED;
        }
        if (wr == 0) PG8_BAR;
        if (ui == 0) pend.wait();
        if constexpr (!Epi::AFTER_DRAIN) E(acc, cur, wr, wc, fr, fq);
        if (!has_next) break;
#pragma unroll
        for (int a = 0; a < 2; ++a)
#pragma unroll
            for (int b = 0; b < 2; ++b)
#pragma unroll
                for (int m = 0; m < 4; ++m)
#pragma unroll
                    for (int n = 0; n < 2; ++n) acc[a][b][m][n] = (f32x4){0.f, 0.f, 0.f, 0.f};
        cur = nxt; cA = nA; cB = nB; ++ui;
        if (wr == 1) PG8_BAR;
    }
    PG8_WAIT_V(0);
    PG8_BAR;
    if constexpr (Epi::AFTER_DRAIN) E.fused(acc, cur, wr, wc, fr, fq, lds, wid, lane);
#undef PG8_SA
#undef PG8_SB
#undef PG8_STAGE
#undef PG8_LDA
#undef PG8_LDB
#undef PG8_MMA
#undef PG8_WAIT_V
#undef PG8_WAIT_L
#undef PG8_BAR
#undef PG8_SCHED
}
}


#define XB_TMO      128
#define XB_XCNT(j)  (256  + 64 * (j))
#define XB_XSUB(j)  (1280 + 64 * (j))
#define XB_XGEN(j)  (2304 + 64 * (j))
#define XB_TOP      3328
#define XB_TOPGEN   3392
#define XCD_BAR_WORDS 3456
#define XB_SPIN_CAP (1u << 22)
__device__ __forceinline__ unsigned xb_ld(unsigned* p)              { return __hip_atomic_load(p, __ATOMIC_RELAXED, __HIP_MEMORY_SCOPE_AGENT); }
__device__ __forceinline__ unsigned xb_add(unsigned* p, unsigned v) { return __hip_atomic_fetch_add(p, v, __ATOMIC_RELAXED, __HIP_MEMORY_SCOPE_AGENT); }
__device__ __forceinline__ unsigned xb_xcc_id() { return (unsigned)__builtin_amdgcn_s_getreg((3 << 11) | 20) & 0xFu; }
#define XB_SPIN(cond, bar) do { unsigned _sp = 0; while (cond) { __builtin_amdgcn_s_sleep(1); \
    if ((++_sp & 255u) == 0u) { if (xb_ld(&(bar)[XB_TMO])) break; if (_sp > XB_SPIN_CAP) { atomicAdd(&(bar)[XB_TMO], 1u); break; } } } } while (0)
struct XcdBarrier { unsigned* bar; unsigned x; volatile LAS unsigned* st; };
__device__ __forceinline__ XcdBarrier xcd_barrier_post(unsigned* bar, volatile LAS unsigned* st) {
    XcdBarrier b; b.bar = bar; b.x = xb_xcc_id(); b.st = st;
    if (threadIdx.x == 0) (void)xb_add(&bar[XB_XCNT(b.x)], 1u);
    return b;
}
__device__ __forceinline__ void xcd_barrier_complete(unsigned* bar, unsigned x, unsigned& nloc, unsigned& nx) {
    const unsigned G = gridDim.x * gridDim.y * gridDim.z;
    unsigned sum, cnt, mine, sp = 0u;
    for (;;) {
        sum = 0u; cnt = 0u; mine = 0u;
#pragma unroll
        for (unsigned j = 0; j < 16; ++j) { const unsigned c = xb_ld(&bar[XB_XCNT(j)]); sum += c; cnt += (c > 0u) ? 1u : 0u; mine = (j == x) ? c : mine; }
        if (sum == G) break;
        __builtin_amdgcn_s_sleep(1);
        if ((++sp & 255u) == 0u) { if (xb_ld(&bar[XB_TMO])) break; if (sp > XB_SPIN_CAP) { atomicAdd(&bar[XB_TMO], 1u); break; } }
    }
    nloc = mine > 0u ? mine : 1u; nx = cnt > 0u ? cnt : 1u;
}
__device__ __forceinline__ void xcd_arrive(const XcdBarrier& b) {
    asm volatile("s_waitcnt vmcnt(0)" ::: "memory");
    __syncthreads();
    if (threadIdx.x == 0) {
        unsigned* bar = b.bar;
        __builtin_amdgcn_s_waitcnt(0);
        unsigned nloc = b.st[0], nx = b.st[1];
        if (nloc == 0u) { xcd_barrier_complete(bar, b.x, nloc, nx); b.st[0] = nloc; b.st[1] = nx; }
        const unsigned old = xb_add(&bar[XB_XSUB(b.x)], 1u);
        const unsigned gen = old / nloc;
        if (old + 1u == (gen + 1u) * nloc) {
            __builtin_amdgcn_fence(__ATOMIC_RELEASE, "agent");
            asm volatile("s_waitcnt vmcnt(0)" ::: "memory");
            (void)xb_add(&bar[XB_TOP], 1u);
        }
        b.st[2] = (gen + 1u) * nx;
    }
}
__device__ __forceinline__ void xcd_wait(const XcdBarrier& b) {
    if (threadIdx.x == 0) {
        unsigned* bar = b.bar; const unsigned want = b.st[2];
        XB_SPIN(xb_ld(&bar[XB_TOP]) < want, bar);
        __builtin_amdgcn_fence(__ATOMIC_ACQUIRE, "agent");
        asm volatile("s_waitcnt vmcnt(0)" ::: "memory");
    }
    __syncthreads();
}
__device__ __forceinline__ void xcd_barrier(const XcdBarrier& b) { xcd_arrive(b); xcd_wait(b); }
struct NoPend    { __device__ __forceinline__ void early() const {} __device__ __forceinline__ void wait() const {} };
struct BarPend   { const XcdBarrier* b; __device__ __forceinline__ void early() const {} __device__ __forceinline__ void wait() const { xcd_wait(*b); } };
struct EarlyPend { const XcdBarrier* b; __device__ __forceinline__ void early() const { xcd_wait(*b); } __device__ __forceinline__ void wait() const {} };
constexpr size_t WS_BAR = WS_LSE + 512 * 1024, WS_CNT0 = WS_BAR + 16384, WS_CNT1 = WS_BAR + 32768, WS_XB0 = WS_LSE + 768 * 1024, WS_XB1 = WS_WSB + 256 * 1024;
constexpr int MISC_OFF = LDS_BYTES - 128;

struct Args {
    const float* x; const float* even_norm; const float* even_w_in; const float* even_pool_w; const float* even_pool_scale; const float* even_ws; const float* even_bs;
    const float* even_w_out; const float* odd_norm; const float* odd_w_in; const float* odd_conv_w; const float* odd_w_out; const float* final_norm;
    float* out; unsigned char* ws; int ph_lo, ph_hi;
};

__device__ __forceinline__ size_t wt_off(int K, int n, int k) {
    const int nl = n & 127, x = nl & 31, rho = 16 * ((x >> 2) & 1) + 4 * (x >> 3) + (x & 3);
    const int R = (nl & ~31) + rho;
    return ((size_t)(n >> 7) * (K >> 6) + (k >> 6)) * (pg8::HTB / 2) + (size_t)(pg8::lds_byte(R, k & 63) >> 1);
}
struct TItem { const float* W; bf16_t* WT; int N, K, k0, nsrc0, ndst0; };
__device__ __forceinline__ void titem_load(const TItem& t, f32x4 (&v)[8], int lane) {
#pragma unroll
    for (int i = 0; i < 8; ++i) v[i] = *(const f32x4*)(t.W + (size_t)(t.k0 + 8 * i + (lane >> 3)) * t.N + t.nsrc0 + 4 * (lane & 7));
}
__device__ __forceinline__ void titem_finish(const TItem& t, const f32x4 (&v)[8], LAS float* scr, int lane) {
#pragma unroll
    for (int i = 0; i < 8; ++i) { LAS float* d = scr + (8 * i + (lane >> 3)) * 33 + 4 * (lane & 7); d[0] = v[i][0]; d[1] = v[i][1]; d[2] = v[i][2]; d[3] = v[i][3]; }
    asm volatile("s_waitcnt lgkmcnt(0)" ::: "memory");
    const int c = lane & 7;
#pragma unroll
    for (int j = 0; j < 4; ++j) { const int n = (lane >> 3) + 8 * j; const LAS float* sp = scr + (8 * c) * 33 + n;
        u32x4 o; o.x = cvt_pk_bf16(sp[0 * 33], sp[1 * 33]); o.y = cvt_pk_bf16(sp[2 * 33], sp[3 * 33]); o.z = cvt_pk_bf16(sp[4 * 33], sp[5 * 33]); o.w = cvt_pk_bf16(sp[6 * 33], sp[7 * 33]);
        *(u32x4*)(t.WT + wt_off(t.K, t.ndst0 + n, t.k0 + 8 * c)) = o; }
    asm volatile("s_waitcnt lgkmcnt(0)" ::: "memory");
}
__device__ __forceinline__ int w1_dst_row(int n) {
    if (n < 2048) return n;
    if (n < 3072) { const int ch = n - 2048; return 3072 + (ch / 128) * 256 + ch % 128; }
    if (n < 4096) return n - 1024;
    { const int ch = n - 4096; return 3072 + (ch / 128) * 256 + 128 + ch % 128; }
}
__device__ __forceinline__ int w3_dst_row(int n) {
    if (n < 9216) { const int which = n / 3072, rem = n % 3072, gi = rem / 1024, j = rem % 1024; return gi * 3072 + which * 1024 + j; }
    if (n < 10240) return n + 2048;
    const int rel = n - 10240, type = rel / 1024, ch = rel % 1024, t128 = ch / 128, within = ch % 128;
    if (type == 1 || type == 2) return 9216 + t128 * 256 + (type == 1 ? 0 : 128) + within;
    return 12288 + t128 * 256 + (type == 0 ? 0 : 128) + within;
}
__device__ __forceinline__ TItem w3_item(const float* W, bf16_t* W3T, int col0, int nb, int idx) { const int kb = idx / nb, nbk = idx % nb, src = col0 + nbk * 32; return TItem{W, W3T, ODD_IN, DM, kb * 64, src, w3_dst_row(src)}; }
__device__ __forceinline__ TItem wo_item(const float* W, bf16_t* WT, int idx) { const int kb = idx / 32, nbk = idx % 32; return TItem{W, WT, DM, DI, kb * 64, nbk * 32, nbk * 32}; }
__device__ __forceinline__ TItem qkv_item(const float* W, bf16_t* W3T, int gi, int r) { const int which = r / 512; return w3_item(W, W3T, which * 3072 + gi * 1024, 32, r % 512); }
template <int SEAM>
__device__ __forceinline__ void seam_convert(const float* w_out_even, const float* w_in_odd, const float* w_out_odd, bf16_t* W2T, bf16_t* W3T, bf16_t* W4T, LAS float* scr, int gw, int NGW, int lane) {
    constexpr int total = (SEAM == 1) ? 2048 : (SEAM == 2) ? 1536 : (SEAM == 3) ? 2048 : (SEAM == 4) ? 2048 : 1536;
    for (int i = gw; i < total; i += NGW) {
        TItem T;
        if (SEAM == 1) { if (i < 1024) T = wo_item(w_out_even, W2T, i); else T = qkv_item(w_in_odd, W3T, 0, i - 1024); }
        else if (SEAM == 2) { if (i < 512) T = qkv_item(w_in_odd, W3T, 0, 1024 + i); else T = wo_item(w_out_odd, W4T, i - 512); }
        else if (SEAM == 3) { if (i < 1536) T = qkv_item(w_in_odd, W3T, 1, i); else T = w3_item(w_in_odd, W3T, 11264, 64, i - 1536); }
        else if (SEAM == 4) { if (i < 1536) T = qkv_item(w_in_odd, W3T, 2, i); else T = w3_item(w_in_odd, W3T, 11264, 64, 512 + (i - 1536)); }
        else { if (i < 512) T = w3_item(w_in_odd, W3T, 9216, 32, i); else if (i < 1024) T = w3_item(w_in_odd, W3T, 10240, 32, i - 512); else T = w3_item(w_in_odd, W3T, 13312, 32, i - 1024); }
        f32x4 v[8]; titem_load(T, v, lane); titem_finish(T, v, scr, lane);
    }
}
__device__ __forceinline__ void rms_row_bf16(const float* xrow, const float* g, bf16_t* orow, int lane) {
    const f32x4* xr = (const f32x4*)xrow + lane; const f32x4* gr = (const f32x4*)g + lane;
    f32x4 v[4]; float s = 0.f;
#pragma unroll
    for (int j = 0; j < 4; ++j) { v[j] = xr[64 * j]; s += (v[j].x * v[j].x + v[j].y * v[j].y) + (v[j].z * v[j].z + v[j].w * v[j].w); }
    const float rstd = rsqrtf(wave_sum(s) * (1.f / DM) + EPS);
    u32x2* o8 = (u32x2*)orow + lane;
#pragma unroll
    for (int j = 0; j < 4; ++j) { const f32x4 gg = gr[64 * j]; u32x2 w; w.x = cvt_pk_bf16(v[j].x * rstd * gg.x, v[j].y * rstd * gg.y); w.y = cvt_pk_bf16(v[j].z * rstd * gg.z, v[j].w * rstd * gg.w); o8[64 * j] = w; }
}
__device__ __forceinline__ void rms_row2_bf16(const float* xa, const float* xb, const float* g, bf16_t* XNt  , int ma, int mb, int lane) {
    const f32x4* pa = (const f32x4*)xa + lane; const f32x4* pb = (const f32x4*)xb + lane; const f32x4* gr = (const f32x4*)g + lane;
    f32x4 va[4], vb[4]; float sa = 0.f, sb = 0.f;
#pragma unroll
    for (int j = 0; j < 4; ++j) { va[j] = pa[64 * j]; vb[j] = pb[64 * j]; }
#pragma unroll
    for (int j = 0; j < 4; ++j) { sa += (va[j].x * va[j].x + va[j].y * va[j].y) + (va[j].z * va[j].z + va[j].w * va[j].w); sb += (vb[j].x * vb[j].x + vb[j].y * vb[j].y) + (vb[j].z * vb[j].z + vb[j].w * vb[j].w); }
    const float ra = rsqrtf(wave_sum(sa) * (1.f / DM) + EPS), rb = rsqrtf(wave_sum(sb) * (1.f / DM) + EPS);
#pragma unroll
    for (int j = 0; j < 4; ++j) { const f32x4 gg = gr[64 * j]; u32x2 w;
        w.x = cvt_pk_bf16(va[j].x * ra * gg.x, va[j].y * ra * gg.y); w.y = cvt_pk_bf16(va[j].z * ra * gg.z, va[j].w * ra * gg.w); *(u32x2*)(XNt + pg8::a_off(DM, ma, (64 * j + lane) * 4)) = w;
        w.x = cvt_pk_bf16(vb[j].x * rb * gg.x, vb[j].y * rb * gg.y); w.y = cvt_pk_bf16(vb[j].z * rb * gg.z, vb[j].w * rb * gg.w); *(u32x2*)(XNt + pg8::a_off(DM, mb, (64 * j + lane) * 4)) = w; }
}
__device__ __forceinline__ void fold_item(const float* Win, const float* PW, bf16_t* W1T, LAS float* sm, int item, int tid) {
    LAS float* As = sm;
    LAS float* Bs = sm + 64 * 33;
    const int k0 = (item >> 4) * 64, n0 = (item & 15) * 64, g = n0 >> 8, d0 = n0 & 255;
    const int tk = tid >> 4, tn = tid & 15;
    float acc[2][4];
#pragma unroll
    for (int i = 0; i < 2; ++i)
#pragma unroll
        for (int j = 0; j < 4; ++j) acc[i][j] = 0.f;
    float ra[4], rb[4];
#pragma unroll
    for (int i = 0; i < 4; ++i) { const int idx = tid + 512 * i; ra[i] = Win[(size_t)(k0 + (idx >> 5)) * EVEN_IN + g * 256 + (idx & 31)]; rb[i] = PW[((size_t)(g * 256 + (idx >> 6))) * 256 + d0 + (idx & 63)]; }
    for (int c0 = 0; c0 < 256; c0 += 32) {
        __syncthreads();
#pragma unroll
        for (int i = 0; i < 4; ++i) { const int idx = tid + 512 * i; As[(idx >> 5) * 33 + (idx & 31)] = ra[i]; Bs[(idx >> 6) * 64 + (idx & 63)] = rb[i]; }
        __syncthreads();
        if (c0 + 32 < 256) {
#pragma unroll
            for (int i = 0; i < 4; ++i) { const int idx = tid + 512 * i; ra[i] = Win[(size_t)(k0 + (idx >> 5)) * EVEN_IN + g * 256 + c0 + 32 + (idx & 31)]; rb[i] = PW[((size_t)(g * 256 + c0 + 32 + (idx >> 6))) * 256 + d0 + (idx & 63)]; }
        }
#pragma unroll 8
        for (int c = 0; c < 32; ++c) { const float a0 = As[(2 * tk) * 33 + c], a1 = As[(2 * tk + 1) * 33 + c]; const f32x4 b = *(const LAS f32x4*)(Bs + c * 64 + 4 * tn);
#pragma unroll
            for (int j = 0; j < 4; ++j) { acc[0][j] += a0 * b[j]; acc[1][j] += a1 * b[j]; } }
    }
#pragma unroll
    for (int j = 0; j < 4; ++j) *(unsigned*)(W1T + wt_off(DM, n0 + 4 * tn + j, k0 + 2 * tk)) = cvt_pk_bf16(acc[0][j], acc[1][j]);
}

__device__ __forceinline__ void unpack8(const u32x4 v, float (&f)[8]) { f[0] = bf_lo(v.x); f[1] = bf_hi(v.x); f[2] = bf_lo(v.y); f[3] = bf_hi(v.y); f[4] = bf_lo(v.z); f[5] = bf_hi(v.z); f[6] = bf_lo(v.w); f[7] = bf_hi(v.w); }
template <int W>
__device__ __forceinline__ void ya_run(const bf16_t* Z1, const float* scale, bf16_t* Y1, int t0, int oc) {
    const int tl0 = t0 & (SEQ - 1);
    constexpr int RUN = 8;
    u32x4 R[W + RUN - 1];
#pragma unroll
    for (int k = 0; k < W + RUN - 1; ++k) { const int dt = k - (W - 1); R[k] = (tl0 + dt >= 0) ? *(const u32x4*)(Z1 + (size_t)(t0 + dt) * ZP + oc * 8) : (u32x4){0u, 0u, 0u, 0u}; }
    const f32x4 sc0 = *(const f32x4*)(scale + oc * 8), sc1 = *(const f32x4*)(scale + oc * 8 + 4);
    const float sc[8] = {sc0[0], sc0[1], sc0[2], sc0[3], sc1[0], sc1[1], sc1[2], sc1[3]};
    float s[8];
#pragma unroll
    for (int e = 0; e < 8; ++e) s[e] = 0.f;
#pragma unroll
    for (int k = 0; k < W - 1; ++k) { float f[8]; unpack8(R[k], f);
#pragma unroll
        for (int e = 0; e < 8; ++e) s[e] += f[e]; }
    u32x4 GA[RUN];
#pragma unroll
    for (int i = 0; i < RUN; ++i) GA[i] = *(const u32x4*)(Z1 + (size_t)(t0 + i) * ZP + 1024 + oc * 8);
#pragma unroll
    for (int i = 0; i < RUN; ++i) {
        float cur[8]; unpack8(R[i + W - 1], cur);
#pragma unroll
        for (int e = 0; e < 8; ++e) s[e] += cur[e];
        if (i > 0) { u32x4 tmp = R[i - 1]; asm volatile("" : "+v"(tmp)); float old[8]; unpack8(tmp, old);
#pragma unroll
            for (int e = 0; e < 8; ++e) s[e] -= old[e]; }
        const int tl = tl0 + i; const float inv = 1.0f / (float)((tl + 1 < W) ? tl + 1 : W);
        float gg[8]; unpack8(GA[i], gg);
        float o[8];
#pragma unroll
        for (int e = 0; e < 8; ++e) o[e] = (s[e] * inv - cur[e]) * sc[e] * gg[e];
        u32x4 w4; w4.x = cvt_pk_bf16(o[0], o[1]); w4.y = cvt_pk_bf16(o[2], o[3]); w4.z = cvt_pk_bf16(o[4], o[5]); w4.w = cvt_pk_bf16(o[6], o[7]);
        *(u32x4*)(Y1 + pg8::a_off(DI, t0 + i, oc * 8)) = w4;
    }
}
__device__ __forceinline__ void ya_phase(const bf16_t* Z1, const float* scale, bf16_t* Y1, int gw, int NGW, int lane) {
    for (int it = gw; it < 4 * 1024; it += NGW) {
        const int g = it & 3, rp = it >> 2;
        const int t0 = (rp * 2 + (lane >> 5)) * 8, oc = g * 32 + (lane & 31);
        if (g == 0) ya_run<2>(Z1, scale, Y1, t0, oc); else if (g == 1) ya_run<4>(Z1, scale, Y1, t0, oc); else if (g == 2) ya_run<8>(Z1, scale, Y1, t0, oc); else ya_run<16>(Z1, scale, Y1, t0, oc);
    }
}
constexpr int VB_STRIDE = 544;
__device__ __forceinline__ void yb_phase(LAS unsigned char* lds, const bf16_t* Z1, const bf16_t* WSB, const float* bs, bf16_t* Y1, int G, int bid) {
    int tid = threadIdx.x; asm volatile("" : "+v"(tid));
    const int lane = tid & 63, w = __builtin_amdgcn_readfirstlane(tid >> 6), ql = lane & 15, gq = lane >> 4;
    for (int unit = bid; unit < 512; unit += G) {
        const int ck = unit >> 2, g = unit & 3, row0 = ck * 128;
        __syncthreads();
#pragma unroll
        for (int i = 0; i < 8; ++i) { const int idx = tid + 512 * i, rr = idx >> 5, ch = idx & 31;
            const u32x4 val = *(const u32x4*)(Z1 + (size_t)(row0 + rr) * ZP + 2048 + 256 * g + ch * 8);
            *(LAS u32x4*)(lds + rr * VB_STRIDE + ch * 16) = val; }
        __syncthreads();
        const int t = 16 * w + ql;
        bf16x8 wf[4];
#pragma unroll
        for (int ks = 0; ks < 4; ++ks) wf[ks] = *(const bf16x8*)(WSB + (size_t)(g * 128 + t) * 128 + 32 * ks + 8 * gq);
        const int nks = (w >> 1) + 1;
        const size_t rowg = (size_t)(row0 + t);
        const float bias = bs[g * 128 + t];
        const LAS unsigned char* vbase = lds + (8 * gq + (ql >> 2)) * VB_STRIDE + (ql & 3) * 8;
        u32x2 ua[16];
#pragma unroll
        for (int cb = 0; cb < 16; ++cb) { const int c0 = 256 * g + 16 * cb + 4 * gq; ua[cb] = *(const u32x2*)(Z1 + rowg * ZP + 3072 + c0); }
#pragma unroll
        for (int cb = 0; cb < 16; ++cb) {
            f32x4 acc = {0.f, 0.f, 0.f, 0.f};
#pragma unroll
            for (int ks = 0; ks < 4; ++ks) {
                if (ks < nks) {
                    const LAS unsigned char* p = vbase + ks * 32 * VB_STRIDE + cb * 32;
                    const s16x4 lo = tr_read(p), hi = tr_read(p + 4 * VB_STRIDE);
                    acc = __builtin_amdgcn_mfma_f32_16x16x32_bf16(cat8(lo, hi), wf[ks], acc, 0, 0, 0);
                }
            }
            const int c0 = 256 * g + 16 * cb + 4 * gq;
            const u32x2 u2 = ua[cb];
            const float o0 = bf_lo(u2.x) * (acc[0] + bias), o1 = bf_hi(u2.x) * (acc[1] + bias);
            const float o2 = bf_lo(u2.y) * (acc[2] + bias), o3 = bf_hi(u2.y) * (acc[3] + bias);
            u32x2 o; o.x = cvt_pk_bf16(o0, o1); o.y = cvt_pk_bf16(o2, o3);
            *(u32x2*)(Y1 + pg8::a_off(DI, (int)rowg, 1024 + c0)) = o;
        }
    }
}

constexpr int KV_STRIDE = 272, KV_BLK = 128 * KV_STRIDE, V_STRIDE = 288, V_BLK = 128 * V_STRIDE, V_BASE = 2 * KV_BLK;
template <int gi>
__device__ __forceinline__ void attn_group_phase(LAS unsigned char* lds, const bf16_t* QKV, bf16_t* O, float* LSE, int G, int bid) {
    int tid = threadIdx.x; asm volatile("" : "+v"(tid));
    const int lane = tid & 63, w = __builtin_amdgcn_readfirstlane(tid >> 6), ql = lane & 15, gq = lane >> 4;
    constexpr int dil = (gi == 0) ? 1 : (gi == 1) ? 4 : 16, nb = 64 / dil, rps = nb / 4;
    for (int job = bid; job < 256; job += G) {
        const int sub = job / rps, n0 = (job % rps) * 4;
        const int r = sub % dil, h = (sub / dil) & 7, b = sub / (dil * 8);
        const float slope = exp2f(-8.0f * (float)(gi * 8 + h + 1) / 24.0f);
        const float c1 = 0.08838834764831845f * 1.4426950408889634f, c2 = slope * (float)dil * 1.4426950408889634f;
        const size_t rowb = (size_t)b * SEQ;
        const int lrow = tid >> 4, lch = tid & 15;
        __syncthreads();
        {
            const int sp = (n0 - 1) & 1;
            LAS unsigned char* kd = lds + sp * KV_BLK; LAS unsigned char* vd = lds + V_BASE + sp * V_BLK;
            if (n0 == 0) {
#pragma unroll
                for (int ps = 0; ps < 4; ++ps) { const int rr = lrow + 32 * ps; *(LAS u32x4*)(kd + rr * KV_STRIDE + lch * 16) = (u32x4){0u, 0u, 0u, 0u}; *(LAS u32x4*)(vd + rr * V_STRIDE + lch * 16) = (u32x4){0u, 0u, 0u, 0u}; }
            } else {
                u32x4 tk[4], tv[4];
#pragma unroll
                for (int ps = 0; ps < 4; ++ps) { const int rr = lrow + 32 * ps; const size_t grow = rowb + (size_t)(128 * (n0 - 1) + rr) * dil + r;
                    const bf16_t* src = QKV + grow * 3072 + h * 128 + lch * 8; tk[ps] = *(const u32x4*)(src + 1024); tv[ps] = *(const u32x4*)(src + 2048); }
#pragma unroll
                for (int ps = 0; ps < 4; ++ps) { const int rr = lrow + 32 * ps; *(LAS u32x4*)(kd + rr * KV_STRIDE + lch * 16) = tk[ps]; *(LAS u32x4*)(vd + rr * V_STRIDE + lch * 16) = tv[ps]; }
            }
        }
        u32x4 pk[4], pv[4];
#pragma unroll
        for (int ps = 0; ps < 4; ++ps) { const int rr = lrow + 32 * ps; const size_t grow = rowb + (size_t)(128 * n0 + rr) * dil + r;
            const bf16_t* src = QKV + grow * 3072 + h * 128 + lch * 8; pk[ps] = *(const u32x4*)(src + 1024); pv[ps] = *(const u32x4*)(src + 2048); }
        for (int n = n0; n < n0 + 4; ++n) {
            const size_t growq = rowb + (size_t)(128 * n + 16 * w + ql) * dil + r;
            bf16x8 qf[4];
#pragma unroll
            for (int ks = 0; ks < 4; ++ks) qf[ks] = *(const bf16x8*)(QKV + growq * 3072 + h * 128 + 32 * ks + 8 * gq);
            {
                const int sc = n & 1;
                LAS unsigned char* kd = lds + sc * KV_BLK; LAS unsigned char* vd = lds + V_BASE + sc * V_BLK;
#pragma unroll
                for (int ps = 0; ps < 4; ++ps) { const int rr = lrow + 32 * ps; *(LAS u32x4*)(kd + rr * KV_STRIDE + lch * 16) = pk[ps]; *(LAS u32x4*)(vd + rr * V_STRIDE + lch * 16) = pv[ps]; }
            }
            __syncthreads();
            float* lsep = LSE + growq * 8 + h;
            bf16_t* op = O + growq * 1024 + h * 128 + 4 * gq;
            float lse_prev = 0.f; u32x2 oprev[8];
            if (gi > 0) { lse_prev = *lsep;
#pragma unroll
                for (int db = 0; db < 8; ++db) oprev[db] = *(const u32x2*)(op + 16 * db); }
            if (n + 1 < n0 + 4) {
#pragma unroll
                for (int ps = 0; ps < 4; ++ps) { const int rr = lrow + 32 * ps; const size_t grow = rowb + (size_t)(128 * (n + 1) + rr) * dil + r;
                    const bf16_t* src = QKV + grow * 3072 + h * 128 + lch * 8; pk[ps] = *(const u32x4*)(src + 1024); pv[ps] = *(const u32x4*)(src + 2048); }
            }
            f32x4 S[9];
#pragma unroll
            for (int kb = 0; kb < 9; ++kb) {
                const int kabs = w + kb, slot = (kabs < 8) ? ((n - 1) & 1) : (n & 1);
                const LAS unsigned char* kp = lds + slot * KV_BLK + ((kabs & 7) * 16 + ql) * KV_STRIDE + gq * 16;
                f32x4 acc = {0.f, 0.f, 0.f, 0.f};
#pragma unroll
                for (int ks = 0; ks < 4; ++ks) acc = __builtin_amdgcn_mfma_f32_16x16x32_bf16(*(const LAS bf16x8*)(kp + 64 * ks), qf[ks], acc, 0, 0, 0);
                S[kb] = acc;
            }
            float mx = -1e30f;
#pragma unroll
            for (int kb = 0; kb < 9; ++kb) {
                const bool blk_ok = (n > 0) || (w + kb >= 8);
#pragma unroll
                for (int e = 0; e < 4; ++e) {
                    const int steps = 128 + ql - 16 * kb - 4 * gq - e;
                    const bool ok = blk_ok && steps >= 0 && steps <= 128;
                    const float v = ok ? S[kb][e] * c1 - c2 * (float)steps : -1e30f;
                    S[kb][e] = v; mx = fmaxf(mx, v);
                }
            }
            mx = fmaxf(mx, __shfl_xor(mx, 16)); mx = fmaxf(mx, __shfl_xor(mx, 32));
            float l = 0.f;
#pragma unroll
            for (int kb = 0; kb < 9; ++kb)
#pragma unroll
                for (int e = 0; e < 4; ++e) { const float p = __builtin_amdgcn_exp2f(S[kb][e] - mx); S[kb][e] = p; l += p; }
            l += __shfl_xor(l, 16); l += __shfl_xor(l, 32);
            f32x4 o[8];
#pragma unroll
            for (int db = 0; db < 8; ++db) o[db] = (f32x4){0.f, 0.f, 0.f, 0.f};
#pragma unroll
            for (int p = 0; p < 5; ++p) {
                const int kx = w + 2 * p, ky = (p < 4) ? kx + 1 : kx;
                const f32x4 X = S[2 * p]; const f32x4 Yv = (p < 4) ? S[(p < 4) ? 2 * p + 1 : 0] : (f32x4){0.f, 0.f, 0.f, 0.f};
                u32x4 pw; pw.x = cvt_pk_bf16(X[0], X[1]); pw.y = cvt_pk_bf16(X[2], X[3]); pw.z = cvt_pk_bf16(Yv[0], Yv[1]); pw.w = cvt_pk_bf16(Yv[2], Yv[3]);
                const bf16x8 pf = __builtin_bit_cast(bf16x8, pw);
                const int sx = (kx < 8) ? ((n - 1) & 1) : (n & 1), sy = (ky < 8) ? ((n - 1) & 1) : (n & 1);
                const LAS unsigned char* vx = lds + V_BASE + sx * V_BLK + ((kx & 7) * 16 + 4 * gq + (ql >> 2)) * V_STRIDE + (ql & 3) * 8;
                const LAS unsigned char* vy = lds + V_BASE + sy * V_BLK + ((ky & 7) * 16 + 4 * gq + (ql >> 2)) * V_STRIDE + (ql & 3) * 8;
#pragma unroll
                for (int db = 0; db < 8; ++db) { const s16x4 lo = tr_read(vx + db * 32), hi = tr_read(vy + db * 32);
                    o[db] = __builtin_amdgcn_mfma_f32_16x16x32_bf16(cat8(lo, hi), pf, o[db], 0, 0, 0); }
            }
            const float inv_l = 1.0f / l;
            const float lse_cur = (mx + __builtin_amdgcn_logf(l)) * 0.6931471805599453f;
            float ca = 0.f, cb = inv_l, lse_new = lse_cur;
            if (gi > 0) {
                const float mm = fmaxf(lse_prev, lse_cur);
                const float wp = __expf(lse_prev - mm), wcur = __expf(lse_cur - mm), inv = 1.0f / (wp + wcur);
                ca = wp * inv; cb = wcur * inv * inv_l; lse_new = mm + __logf(wp + wcur);
            }
#pragma unroll
            for (int db = 0; db < 8; ++db) {
                f32x4 v = o[db] * cb;
                if (gi > 0) { const u32x2 pr = oprev[db]; v[0] += ca * bf_lo(pr.x); v[1] += ca * bf_hi(pr.x); v[2] += ca * bf_lo(pr.y); v[3] += ca * bf_hi(pr.y); }
                u32x2 st; st.x = cvt_pk_bf16(v[0], v[1]); st.y = cvt_pk_bf16(v[2], v[3]);
                *(u32x2*)(op + 16 * db) = st;
            }
            if (gq == 0) *lsep = lse_new;
            __syncthreads();
        }
    }
}


template <int gi>
__device__ __forceinline__ void attn_naive_phase(const bf16_t* QKV, bf16_t* O, float* LSE, int gw, int NGW, int lane) {
    constexpr int dil = (gi == 0) ? 1 : (gi == 1) ? 4 : 16;
    for (int it = gw; it < M_TOK * 8; it += NGW) {
        const int row = it >> 3, h = it & 7, tl = row & (SEQ - 1);
        const float slope = exp2f(-8.0f * (float)(gi * 8 + h + 1) / 24.0f) * (float)dil;
        const unsigned qq = *(const unsigned*)(QKV + (size_t)row * 3072 + h * 128 + 2 * lane);
        const float q0 = bf_lo(qq), q1 = bf_hi(qq);
        float m = -1e30f, l = 0.f, o0 = 0.f, o1 = 0.f;
        for (int j = 0; j <= 128; ++j) {
            if (tl - j * dil < 0) break;
            const size_t kr = (size_t)(row - j * dil) * 3072 + h * 128 + 2 * lane;
            const unsigned kk = *(const unsigned*)(QKV + kr + 1024), vv = *(const unsigned*)(QKV + kr + 2048);
            const float d = wave_sum(q0 * bf_lo(kk) + q1 * bf_hi(kk));
            const float sc = d * 0.08838834764831845f - slope * (float)j;
            const float mn = fmaxf(m, sc), f = __expf(m - mn), p = __expf(sc - mn);
            l = l * f + p; o0 = o0 * f + p * bf_lo(vv); o1 = o1 * f + p * bf_hi(vv); m = mn;
        }
        const float inv_l = 1.0f / l; const float lse_cur = m + __logf(l);
        float ca = 0.f, cb = inv_l, lse_new = lse_cur;
        float* lsep = LSE + (size_t)row * 8 + h;
        unsigned* op = (unsigned*)(O + (size_t)row * 1024 + h * 128 + 2 * lane);
        if (gi > 0) {
            const float lse_prev = *lsep; const float mm = fmaxf(lse_prev, lse_cur);
            const float wp = __expf(lse_prev - mm), wcur = __expf(lse_cur - mm), inv = 1.0f / (wp + wcur);
            ca = wp * inv; cb = wcur * inv * inv_l; lse_new = mm + __logf(wp + wcur);
            const unsigned pr = *op; o0 = o0 * cb + ca * bf_lo(pr); o1 = o1 * cb + ca * bf_hi(pr);
        } else { o0 *= cb; o1 *= cb; }
        *op = cvt_pk_bf16(o0, o1);
        if (lane == 0) *lsep = lse_new;
    }
}

__device__ __forceinline__ void conv_phase(const bf16_t* ZC, const bf16_t* GB, const float* cw, bf16_t* Y2, int gtid, int gthreads) {
    for (int it = gtid; it < (M_TOK / 8) * 128; it += gthreads) {
        const int oc = it & 127, t0 = (it >> 7) * 8, tl0 = t0 & (SEQ - 1);
        u32x4 Z[10], Gv[8];
#pragma unroll
        for (int k = 0; k < 10; ++k) Z[k] = (tl0 + k - 2 >= 0) ? *(const u32x4*)(ZC + (size_t)(t0 + k - 2) * 1024 + oc * 8) : (u32x4){0u, 0u, 0u, 0u};
#pragma unroll
        for (int k = 0; k < 8; ++k) Gv[k] = *(const u32x4*)(GB + (size_t)(t0 + k) * 1024 + oc * 8);
        float w0[8], w1[8], w2[8];
        { const f32x4 a0 = *(const f32x4*)(cw + oc * 8), a1 = *(const f32x4*)(cw + oc * 8 + 4), b0 = *(const f32x4*)(cw + 1024 + oc * 8), b1 = *(const f32x4*)(cw + 1024 + oc * 8 + 4),
                      c0 = *(const f32x4*)(cw + 2048 + oc * 8), c1 = *(const f32x4*)(cw + 2048 + oc * 8 + 4);
#pragma unroll
          for (int e = 0; e < 4; ++e) { w0[e] = a0[e]; w0[4 + e] = a1[e]; w1[e] = b0[e]; w1[4 + e] = b1[e]; w2[e] = c0[e]; w2[4 + e] = c1[e]; } }
#pragma unroll
        for (int i = 0; i < 8; ++i) {
            float z2[8], z1[8], z0[8], gg[8], o[8];
            unpack8(Z[i], z2); unpack8(Z[i + 1], z1); unpack8(Z[i + 2], z0); unpack8(Gv[i], gg);
#pragma unroll
            for (int e = 0; e < 8; ++e) o[e] = gg[e] * (w0[e] * z2[e] + w1[e] * z1[e] + w2[e] * z0[e]);
            u32x4 w4; w4.x = cvt_pk_bf16(o[0], o[1]); w4.y = cvt_pk_bf16(o[2], o[3]); w4.z = cvt_pk_bf16(o[4], o[5]); w4.w = cvt_pk_bf16(o[6], o[7]);
            *(u32x4*)(Y2 + (size_t)(t0 + i) * DI + 1024 + oc * 8) = w4;
        }
    }
}

constexpr int N_PHASES = 16;
__global__ void __launch_bounds__(512) hybrid_fwd(Args a) {
    extern __shared__ __attribute__((aligned(16))) unsigned char lds_raw[];
    LAS unsigned char* lds = (LAS unsigned char*)lds_raw;
    cg::grid_group grid = cg::this_grid();
    const int tid = threadIdx.x, lane = tid & 63, wave = __builtin_amdgcn_readfirstlane(tid >> 6);
    const int G = gridDim.x, bid = blockIdx.x;
    const int gw = bid * 8 + wave, NGW = G * 8;
    const int gtid = bid * 512 + tid, gthreads = G * 512;
    unsigned char* ws = a.ws;
    bf16_t* W1T = (bf16_t*)(ws + WS_W1T); bf16_t* W2T = (bf16_t*)(ws + WS_W2T); bf16_t* W3T = (bf16_t*)(ws + WS_W3T); bf16_t* W4T = (bf16_t*)(ws + WS_W4T);
    bf16_t* WSB = (bf16_t*)(ws + WS_WSB); float* LSE = (float*)(ws + WS_LSE);
    bf16_t* XN = (bf16_t*)(ws + WS_XN); bf16_t* X1 = (bf16_t*)(ws + WS_X1); bf16_t* Z1 = (bf16_t*)(ws + WS_Z1);
    bf16_t* QKV = (bf16_t*)(ws + WS_QKV); bf16_t* Y2 = (bf16_t*)(ws + WS_Y2); bf16_t* GBb = (bf16_t*)(ws + WS_GB);
    bf16_t* Y1 = (bf16_t*)a.out;
    bf16_t* Ob = (bf16_t*)a.out;
    bf16_t* ZC = (bf16_t*)((unsigned char*)a.out + 32 * MiB);
    const int lo = a.ph_lo, hi = a.ph_hi;
#define IN(k) (lo <= (k) && (k) < hi)
    volatile LAS unsigned* MISC = (volatile LAS unsigned*)(lds + MISC_OFF);
    if (tid < 32) MISC[tid] = 0u;
    __syncthreads();
    const XcdBarrier gbar = xcd_barrier_post((unsigned*)(ws + WS_BAR), MISC + 8);
    if (a.ph_hi > 1000) grid.sync();
#define GSYNC() xcd_barrier(gbar)
#define SYNC(k) do { if (IN(k) && IN((k) + 1)) GSYNC(); } while (0)

    if (IN(0)) {
        for (int it = bid; it < 256; it += G) fold_item(a.even_w_in, a.even_pool_w, W1T, (LAS float*)lds, it, tid);
        __syncthreads();
        LAS float* scr = (LAS float*)(lds + wave * 16384);
        constexpr int I1 = 16 * 128, I2 = 0, I3 = 0, ITOT = I1;
#define T_DECODE(it_, T_) do { int r_ = (it_); \
            if (r_ < I1) { const int kb = r_ / 128, nbk = r_ % 128; T_ = TItem{a.even_w_in, W1T, EVEN_IN, DM, kb * 64, 1024 + nbk * 32, w1_dst_row(1024 + nbk * 32)}; } \
            else if ((r_ -= I1) < I2) { const int kb = r_ / 32, nbk = r_ % 32; T_ = TItem{a.even_w_out, W2T, DM, DI, kb * 64, nbk * 32, nbk * 32}; } \
            else if ((r_ -= I2) < I3) { const int kb = r_ / 448, nbk = r_ % 448; T_ = TItem{a.odd_w_in, W3T, ODD_IN, DM, kb * 64, nbk * 32, w3_dst_row(nbk * 32)}; } \
            else { r_ -= I3; const int kb = r_ / 32, nbk = r_ % 32; T_ = TItem{a.odd_w_out, W4T, DM, DI, kb * 64, nbk * 32, nbk * 32}; } } while (0)
        if (gw < ITOT) {
            TItem cur; f32x4 vc[8]; T_DECODE(gw, cur); titem_load(cur, vc, lane);
            for (int it = gw; it < ITOT; it += NGW) {
                TItem nxt = cur; f32x4 vn[8]; const bool has = it + NGW < ITOT;
                if (has) { T_DECODE(it + NGW, nxt); titem_load(nxt, vn, lane); }
                titem_finish(cur, vc, scr, lane);
                if (has) { cur = nxt;
#pragma unroll
                    for (int i = 0; i < 8; ++i) vc[i] = vn[i]; }
            }
        }
#undef T_DECODE
        for (int i = gtid; i < 4 * 128 * 128; i += gthreads) { const int tt = (i >> 7) & 127, ss = i & 127; const float v = (ss <= tt) ? a.even_ws[i] : 0.f; WSB[i] = (bf16_t)(cvt_pk_bf16(v, 0.f) & 0xffffu); }
        for (int m = gw; m < M_TOK; m += 2 * NGW) rms_row2_bf16(a.x + (size_t)m * DM, a.x + (size_t)(m + NGW) * DM, a.even_norm, XN, m, m + NGW, lane);
    }
    SYNC(0);
#ifdef EXP_BAR
    for (int q = 0; q < 10; ++q) GSYNC();
#endif
    if (IN(1)) { pg8::Gemm g{XN, W1T, M_TOK, EVEN_IN, DM}; pg8::StaticOrder S; S.init(M_TOK, EVEN_IN, G, bid); pg8::EpiEven E{Z1}; pg8::gemm_phase(lds, g, S, E, NoPend{}); }
    xcd_arrive(gbar); seam_convert<1>(a.even_w_out, a.odd_w_in, a.odd_w_out, W2T, W3T, W4T, (LAS float*)(lds + wave * 16384), gw, NGW, lane); xcd_wait(gbar);
    if (IN(2)) { ya_phase(Z1, a.even_pool_scale, Y1, gw, NGW, lane); yb_phase(lds, Z1, WSB, a.even_bs, Y1, G, bid); }
    xcd_arrive(gbar); seam_convert<2>(a.even_w_out, a.odd_w_in, a.odd_w_out, W2T, W3T, W4T, (LAS float*)(lds + wave * 16384), gw, NGW, lane);
    if (IN(3)) { pg8::Gemm g{Y1, W2T, M_TOK, DM, DI}; pg8::StaticOrder S; S.init(M_TOK, DM, G, bid);
        pg8::EpiResNorm<true> E{a.x, nullptr, X1, XN, nullptr, a.odd_norm, pg8::PanelSq{(float*)(ws + WS_XB0), (unsigned*)(ws + WS_CNT0)}}; pg8::gemm_phase(lds, g, S, E, EarlyPend{&gbar}); }
    xcd_arrive(gbar); seam_convert<3>(a.even_w_out, a.odd_w_in, a.odd_w_out, W2T, W3T, W4T, (LAS float*)(lds + wave * 16384), gw, NGW, lane); xcd_wait(gbar);
    if (IN(5)) { pg8::Gemm g{XN, W3T, M_TOK, 3072, DM}; pg8::StaticOrder S; S.init(M_TOK, 3072, G, bid); pg8::EpiBf16 E{QKV, 3072}; pg8::gemm_phase(lds, g, S, E, NoPend{}); }
    xcd_arrive(gbar); seam_convert<4>(a.even_w_out, a.odd_w_in, a.odd_w_out, W2T, W3T, W4T, (LAS float*)(lds + wave * 16384), gw, NGW, lane); xcd_wait(gbar);
    attn_group_phase<0>(lds, QKV, Ob, LSE, G, bid);
    xcd_arrive(gbar);
    { pg8::Gemm g{XN, W3T + (size_t)3072 * DM, M_TOK, 3072, DM}; pg8::StaticOrder S; S.init(M_TOK, 3072, G, bid); pg8::EpiBf16 E{QKV, 3072}; pg8::gemm_phase(lds, g, S, E, BarPend{&gbar}); }
    xcd_arrive(gbar); seam_convert<5>(a.even_w_out, a.odd_w_in, a.odd_w_out, W2T, W3T, W4T, (LAS float*)(lds + wave * 16384), gw, NGW, lane); xcd_wait(gbar);
    attn_group_phase<1>(lds, QKV, Ob, LSE, G, bid);
    xcd_arrive(gbar);
    { pg8::Gemm g{XN, W3T + (size_t)2 * 3072 * DM, M_TOK, 5120, DM}; pg8::StaticOrder S; S.init(M_TOK, 5120, G, bid);
        pg8::EpiQkvZc E{pg8::EpiBf16{QKV, 3072}, pg8::EpiPair{ZC, GBb}}; pg8::gemm_phase(lds, g, S, E, BarPend{&gbar}); }
    GSYNC();
    attn_group_phase<2>(lds, QKV, Ob, LSE, G, bid);
    xcd_arrive(gbar);
    { pg8::Gemm g{XN, W3T + (size_t)11264 * DM, M_TOK, 3072, DM}; pg8::StaticOrder S; S.init(M_TOK, 3072, G, bid);
        pg8::EpiGcGb E{pg8::EpiGateMul{Ob, 1024, Y2, DI}, pg8::EpiGateConv{ZC, a.odd_conv_w, Y2}}; pg8::gemm_phase(lds, g, S, E, BarPend{&gbar}); }
    xcd_arrive(gbar);
    if (IN(14)) { pg8::Gemm g{Y2, W4T, M_TOK, DM, DI}; pg8::StaticOrder S; S.init(M_TOK, DM, G, bid);
        pg8::EpiResNorm<false> E{nullptr, X1, nullptr, nullptr, a.out, a.final_norm, pg8::PanelSq{(float*)(ws + WS_XB1), (unsigned*)(ws + WS_CNT1)}}; pg8::gemm_phase(lds, g, S, E, EarlyPend{&gbar}); }
#undef IN
#undef SYNC
}

extern "C" void kernel_launch(void* const* d_in, const int* in_sizes, int n_in, void* d_out, int out_size, void* d_ws, size_t ws_size, hipStream_t stream) {
    static int grid = 0;
    if (grid == 0) {
        int dev = 0, cus = 0, per_cu = 0;
        hipGetDevice(&dev);
        hipDeviceGetAttribute(&cus, hipDeviceAttributeMultiprocessorCount, dev);
        hipFuncSetAttribute((const void*)hybrid_fwd, hipFuncAttributeMaxDynamicSharedMemorySize, LDS_BYTES);
        if (hipOccupancyMaxActiveBlocksPerMultiprocessor(&per_cu, (const void*)hybrid_fwd, 512, LDS_BYTES) != hipSuccess || per_cu < 1) per_cu = 1;
        (void)hipGetLastError();
        grid = cus * per_cu;
        if (grid <= 0) grid = 256;
    }
    Args a{};
    a.x = (const float*)d_in[0]; a.even_norm = (const float*)d_in[1]; a.even_w_in = (const float*)d_in[2]; a.even_pool_w = (const float*)d_in[3];
    a.even_pool_scale = (const float*)d_in[4]; a.even_ws = (const float*)d_in[5]; a.even_bs = (const float*)d_in[6]; a.even_w_out = (const float*)d_in[7];
    a.odd_norm = (const float*)d_in[8]; a.odd_w_in = (const float*)d_in[9]; a.odd_conv_w = (const float*)d_in[10]; a.odd_w_out = (const float*)d_in[11];
    a.final_norm = (const float*)d_in[12];
    a.out = (float*)d_out; a.ws = (unsigned char*)d_ws; a.ph_lo = 0; a.ph_hi = N_PHASES;
    (void)hipMemsetAsync((char*)d_ws + WS_BAR, 0, 49152, stream);
    void* args[] = {&a};
    hipError_t e = hipLaunchCooperativeKernel((const void*)hybrid_fwd, dim3(grid), dim3(512), args, LDS_BYTES, stream);
    if (e != hipSuccess) fprintf(stderr, "cooperative launch failed: %s (grid %d)\n", hipGetErrorString(e), grid);
}
```

```cpp
#define NAIVE_ATTN 0

#include <hip/hip_runtime.h>
#include <hip/hip_cooperative_groups.h>
#include <cstdio>
#include <cstdint>
namespace cg = cooperative_groups;

#define LAS __attribute__((address_space(3)))
typedef unsigned short bf16_t;
typedef short bf16x8 __attribute__((ext_vector_type(8)));
typedef short s16x4 __attribute__((ext_vector_type(4)));
typedef float f32x4 __attribute__((ext_vector_type(4)));
typedef float f32x2 __attribute__((ext_vector_type(2)));
typedef unsigned u32x4 __attribute__((ext_vector_type(4)));
typedef unsigned u32x2 __attribute__((ext_vector_type(2)));

constexpr int M_TOK = 16384, SEQ = 8192, DM = 1024;
constexpr int EVEN_IN = 5120, ODD_IN = 14336, DI = 2048, ZP = 4096;
constexpr float EPS = 1e-6f;
constexpr size_t MiB = 1u << 20;
constexpr size_t WS_W1T = 0, WS_W2T = 10 * MiB, WS_W3T = 14 * MiB, WS_W4T = 42 * MiB, WS_WSB = 46 * MiB, WS_LSE = 47 * MiB;
constexpr size_t WS_XN = 48 * MiB, WS_X1 = 80 * MiB, WS_Z1 = 80 * MiB, WS_QKV = 144 * MiB, WS_Y2 = 144 * MiB, WS_GB = 208 * MiB;
constexpr int LDS_BYTES = 147456;

typedef __bf16 bf16x2_t __attribute__((ext_vector_type(2)));
__device__ __forceinline__ unsigned cvt_pk_bf16(float lo, float hi) { f32x2 v = {lo, hi}; bf16x2_t b = __builtin_convertvector(v, bf16x2_t); return __builtin_bit_cast(unsigned, b); }
__device__ __forceinline__ float bf_lo(unsigned u) { return __uint_as_float(u << 16); }
__device__ __forceinline__ float bf_hi(unsigned u) { return __uint_as_float(u & 0xffff0000u); }
__device__ __forceinline__ float silu_f(float x) { return x * __builtin_amdgcn_rcpf(1.0f + __expf(-x)); }
__device__ __forceinline__ float wave_sum(float v) {
#pragma unroll
    for (int o = 1; o < 64; o <<= 1) v += __shfl_xor(v, o);
    return v;
}
__device__ __forceinline__ s16x4 tr_read(const LAS unsigned char* p) {
    typedef short v4i16_t __attribute__((ext_vector_type(4)));
    return __builtin_bit_cast(s16x4, __builtin_amdgcn_ds_read_tr16_b64_v4i16((LAS v4i16_t*)p));
}
__device__ __forceinline__ bf16x8 cat8(s16x4 lo, s16x4 hi) { return (bf16x8){lo[0], lo[1], lo[2], lo[3], hi[0], hi[1], hi[2], hi[3]}; }

namespace pg8 {
constexpr int BM = 256, BK = 64, HALF = 128, HTB = HALF * BK * 2, STAGE_BYTES = 8 * HTB, NXCD = 8, WGM = 8;
__host__ __device__ __forceinline__ int lds_byte(int r, int c) { const int st = (r >> 4) * 2 + (c >> 5), rr = r & 15, cc = c & 31, ob = rr * 64 + cc * 2; return st * 1024 + (ob ^ (((ob >> 9) & 1) << 5)); }
__host__ __device__ __forceinline__ void stage_rc(int b, int& R, int& C) { const int st = b / 1024, sb = b % 1024, swz = sb ^ (((sb >> 9) & 1) << 5); R = (st >> 1) * 16 + swz / 64; C = (st & 1) * 32 + (swz % 64) / 2; }
__host__ __device__ __forceinline__ int perm32(int rho) { const int n = rho >> 4, i = rho & 15; return 8 * (i >> 2) + 4 * n + (i & 3); }

__host__ __device__ __forceinline__ size_t a_off(int K, int m, int k) { return ((size_t)(m >> 7) * (K >> 6) + (k >> 6)) * (HTB / 2) + (size_t)(lds_byte(m & 127, k & 63) >> 1); }
struct Unit { int pm, pn; };
struct Gemm { const bf16_t* A; const bf16_t* Bt; int M, N, K; };

struct StaticOrder {
    int nM, nN, nwg, G, c;
    __host__ __device__ void init(int M, int N, int G_, int c_) { nM = M / BM; nN = N / BM; nwg = nM * nN; G = G_; c = c_; }
    __host__ __device__ bool next(int i, Unit& u) const {
        const long L = (long)i * G + c; if (L >= nwg) return false;
        int wgid = (int)L; { const int q = nwg / NXCD, r = nwg % NXCD, xcd = wgid % NXCD, off = wgid / NXCD; wgid = (xcd < r ? xcd * (q + 1) : r * (q + 1) + (xcd - r) * q) + off; }
        const int nig = WGM * nN, gid = wgid / nig, fm = gid * WGM, gsz = (nM - fm) < WGM ? (nM - fm) : WGM;
        u.pm = fm + ((wgid % nig) % gsz); u.pn = (wgid % nig) / gsz; return true;
    }
};

struct EpiBf16 {
    static constexpr bool AFTER_DRAIN = false; static constexpr bool HAS_INIT = false;
    static constexpr bool PERM = true;
    bf16_t* O; int ldc;
    __device__ __forceinline__ void operator()(const f32x4 (&acc)[2][2][4][2], const Unit& u, int wr, int wc, int fr, int fq) const {
        const int row0 = u.pm * BM + wr * 64 + fr; const int col0 = u.pn * BM + wc * 32 + 8 * fq;
#pragma unroll
        for (int ai = 0; ai < 2; ++ai)
#pragma unroll
            for (int m = 0; m < 4; ++m) { bf16_t* rowp = O + (size_t)(row0 + ai * HALF + m * 16) * ldc + col0;
#pragma unroll
                for (int bj = 0; bj < 2; ++bj) { const f32x4 v0 = acc[ai][bj][m][0], v1 = acc[ai][bj][m][1];
                    u32x4 w; w.x = cvt_pk_bf16(v0[0], v0[1]); w.y = cvt_pk_bf16(v0[2], v0[3]); w.z = cvt_pk_bf16(v1[0], v1[1]); w.w = cvt_pk_bf16(v1[2], v1[3]);
                    *(u32x4*)(rowp + bj * HALF) = w; } }
    }
};
struct EpiResF32 {
    static constexpr bool AFTER_DRAIN = false; static constexpr bool HAS_INIT = false;
    static constexpr bool PERM = false;
    const float* base; float* out; int ldc;
    __device__ __forceinline__ void operator()(const f32x4 (&acc)[2][2][4][2], const Unit& u, int wr, int wc, int fr, int fq) const {
        const int col0 = u.pn * BM + wc * 32 + 4 * fq;
#pragma unroll
        for (int ai = 0; ai < 2; ++ai)
#pragma unroll
            for (int m = 0; m < 4; ++m) { const size_t off = (size_t)(u.pm * BM + ai * HALF + wr * 64 + m * 16 + fr) * ldc + col0;
#pragma unroll
                for (int bj = 0; bj < 2; ++bj)
#pragma unroll
                    for (int n = 0; n < 2; ++n) { const f32x4 bs = *(const f32x4*)(base + off + bj * HALF + n * 16); *(f32x4*)(out + off + bj * HALF + n * 16) = bs + acc[ai][bj][m][n]; } }
    }
};
struct EpiGateMul {
    static constexpr bool AFTER_DRAIN = false; static constexpr bool HAS_INIT = false;
    static constexpr bool PERM = true;
    const bf16_t* Oin; int ldo; bf16_t* Y; int ldy;
    __device__ __forceinline__ void operator()(const f32x4 (&acc)[2][2][4][2], const Unit& u, int wr, int wc, int fr, int fq) const {
        const int row0 = u.pm * BM + wr * 64 + fr; const int col0 = u.pn * BM + wc * 32 + 8 * fq;
#pragma unroll
        for (int ai = 0; ai < 2; ++ai)
#pragma unroll
            for (int m = 0; m < 4; ++m) { const size_t row = (size_t)(row0 + ai * HALF + m * 16);
#pragma unroll
                for (int bj = 0; bj < 2; ++bj) { const f32x4 v0 = acc[ai][bj][m][0], v1 = acc[ai][bj][m][1];
                    const u32x4 o = *(const u32x4*)(Oin + row * ldo + col0 + bj * HALF);
                    u32x4 w;
                    w.x = cvt_pk_bf16(bf_lo(o.x) * silu_f(v0[0]), bf_hi(o.x) * silu_f(v0[1])); w.y = cvt_pk_bf16(bf_lo(o.y) * silu_f(v0[2]), bf_hi(o.y) * silu_f(v0[3]));
                    w.z = cvt_pk_bf16(bf_lo(o.z) * silu_f(v1[0]), bf_hi(o.z) * silu_f(v1[1])); w.w = cvt_pk_bf16(bf_lo(o.w) * silu_f(v1[2]), bf_hi(o.w) * silu_f(v1[3]));
                    *(u32x4*)(Y + a_off(ldy, (int)row, col0 + bj * HALF)) = w; } }
    }
};
struct EpiPair {
    static constexpr bool AFTER_DRAIN = false; static constexpr bool HAS_INIT = false;
    static constexpr bool PERM = true;
    bf16_t* ZC; bf16_t* GB;
    __device__ __forceinline__ void operator()(const f32x4 (&acc)[2][2][4][2], const Unit& u, int wr, int wc, int fr, int fq) const {
        const int row0 = u.pm * BM + wr * 64 + fr; const bool gate = u.pn >= 8; const int ct = gate ? u.pn - 8 : u.pn;
        bf16_t* dstb = gate ? GB : ZC; const int dcol = ct * 128 + wc * 32 + 8 * fq;
#pragma unroll
        for (int ai = 0; ai < 2; ++ai)
#pragma unroll
            for (int m = 0; m < 4; ++m) { const size_t row = (size_t)(row0 + ai * HALF + m * 16);
                f32x4 p0 = acc[ai][0][m][0], p1 = acc[ai][0][m][1], q0 = acc[ai][1][m][0], q1 = acc[ai][1][m][1];
                if (gate) {
#pragma unroll
                    for (int e = 0; e < 4; ++e) { q0[e] = silu_f(q0[e]); q1[e] = silu_f(q1[e]); } }
                p0 = p0 * q0; p1 = p1 * q1;
                u32x4 w; w.x = cvt_pk_bf16(p0[0], p0[1]); w.y = cvt_pk_bf16(p0[2], p0[3]); w.z = cvt_pk_bf16(p1[0], p1[1]); w.w = cvt_pk_bf16(p1[2], p1[3]);
                *(u32x4*)(dstb + a_off(1024, (int)row, dcol)) = w; }
    }
};


struct EpiGateConv {
    static constexpr bool AFTER_DRAIN = false; static constexpr bool HAS_INIT = false;
    static constexpr bool PERM = true;
    const bf16_t* ZC; const float* cw; bf16_t* Y2;
    __device__ __forceinline__ void operator()(const f32x4 (&acc)[2][2][4][2], const Unit& u, int wr, int wc, int fr, int fq) const {
        const int row0 = u.pm * BM + wr * 64 + fr; const int ch0 = u.pn * 128 + wc * 32 + 8 * fq;
        const f32x4 wa0 = *(const f32x4*)(cw + ch0), wa1 = *(const f32x4*)(cw + ch0 + 4), wb0 = *(const f32x4*)(cw + 1024 + ch0), wb1 = *(const f32x4*)(cw + 1024 + ch0 + 4),
                    wc0 = *(const f32x4*)(cw + 2048 + ch0), wc1 = *(const f32x4*)(cw + 2048 + ch0 + 4);
#pragma unroll
        for (int ai = 0; ai < 2; ++ai)
#pragma unroll
            for (int m = 0; m < 4; ++m) { const int row = row0 + ai * HALF + m * 16; const int tl = row & (SEQ - 1);
                const bf16_t* zp = ZC + a_off(1024, row, ch0);
                const u32x4 z0 = *(const u32x4*)zp;
                const u32x4 z1 = (tl >= 1) ? *(const u32x4*)(ZC + a_off(1024, row - 1, ch0)) : (u32x4){0u, 0u, 0u, 0u};
                const u32x4 z2 = (tl >= 2) ? *(const u32x4*)(ZC + a_off(1024, row - 2, ch0)) : (u32x4){0u, 0u, 0u, 0u};
                f32x4 p0 = acc[ai][0][m][0], p1 = acc[ai][0][m][1]; const f32x4 q0 = acc[ai][1][m][0], q1 = acc[ai][1][m][1];
#pragma unroll
                for (int e = 0; e < 4; ++e) { p0[e] *= silu_f(q0[e]); p1[e] *= silu_f(q1[e]); }
                const f32x4 a0 = {bf_lo(z0.x), bf_hi(z0.x), bf_lo(z0.y), bf_hi(z0.y)}, a1 = {bf_lo(z0.z), bf_hi(z0.z), bf_lo(z0.w), bf_hi(z0.w)};
                const f32x4 b0 = {bf_lo(z1.x), bf_hi(z1.x), bf_lo(z1.y), bf_hi(z1.y)}, b1 = {bf_lo(z1.z), bf_hi(z1.z), bf_lo(z1.w), bf_hi(z1.w)};
                const f32x4 c0 = {bf_lo(z2.x), bf_hi(z2.x), bf_lo(z2.y), bf_hi(z2.y)}, c1 = {bf_lo(z2.z), bf_hi(z2.z), bf_lo(z2.w), bf_hi(z2.w)};
                p0 = p0 * (wa0 * c0 + wb0 * b0 + wc0 * a0); p1 = p1 * (wa1 * c1 + wb1 * b1 + wc1 * a1);
                u32x4 w; w.x = cvt_pk_bf16(p0[0], p0[1]); w.y = cvt_pk_bf16(p0[2], p0[3]); w.z = cvt_pk_bf16(p1[0], p1[1]); w.w = cvt_pk_bf16(p1[2], p1[3]);
                *(u32x4*)(Y2 + a_off(DI, row, 1024 + ch0)) = w; }
    }
};

struct EpiQkvZc {
    static constexpr bool AFTER_DRAIN = false, PERM = true, HAS_INIT = false;
    EpiBf16 e0; EpiPair e1;
    __device__ __forceinline__ void operator()(const f32x4 (&acc)[2][2][4][2], const Unit& u, int wr, int wc, int fr, int fq) const {
        if (u.pn < 12) e0(acc, u, wr, wc, fr, fq); else { Unit v = u; v.pn -= 12; e1(acc, v, wr, wc, fr, fq); }
    }
};
struct EpiGcGb {
    static constexpr bool AFTER_DRAIN = false, PERM = true, HAS_INIT = false;
    EpiGateMul e0; EpiGateConv e1;
    __device__ __forceinline__ void operator()(const f32x4 (&acc)[2][2][4][2], const Unit& u, int wr, int wc, int fr, int fq) const {
        if (u.pn < 4) e0(acc, u, wr, wc, fr, fq); else { Unit v = u; v.pn -= 4; e1(acc, v, wr, wc, fr, fq); }
    }
};

struct EpiEven {
    static constexpr bool AFTER_DRAIN = false, PERM = true, HAS_INIT = false;
    bf16_t* Z;
    __device__ __forceinline__ void operator()(const f32x4 (&acc)[2][2][4][2], const Unit& u, int wr, int wc, int fr, int fq) const {
        const int row0 = u.pm * BM + wr * 64 + fr;
        if (u.pn < 12) {
            const bool act = (u.pn >= 4) && (u.pn < 8); const int col0 = u.pn * BM + wc * 32 + 8 * fq;
#pragma unroll
            for (int ai = 0; ai < 2; ++ai)
#pragma unroll
                for (int m = 0; m < 4; ++m) { bf16_t* rowp = Z + (size_t)(row0 + ai * HALF + m * 16) * ZP + col0;
#pragma unroll
                    for (int bj = 0; bj < 2; ++bj) { f32x4 v0 = acc[ai][bj][m][0], v1 = acc[ai][bj][m][1];
                        if (act) {
#pragma unroll
                            for (int e = 0; e < 4; ++e) { v0[e] = silu_f(v0[e]); v1[e] = silu_f(v1[e]); } }
                        u32x4 w; w.x = cvt_pk_bf16(v0[0], v0[1]); w.y = cvt_pk_bf16(v0[2], v0[3]); w.z = cvt_pk_bf16(v1[0], v1[1]); w.w = cvt_pk_bf16(v1[2], v1[3]);
                        *(u32x4*)(rowp + bj * HALF) = w; } }
        } else {
            bf16_t* dst = Z + 3072 + (u.pn - 12) * 128 + wc * 32 + 8 * fq;
#pragma unroll
            for (int ai = 0; ai < 2; ++ai)
#pragma unroll
                for (int m = 0; m < 4; ++m) { const size_t row = (size_t)(row0 + ai * HALF + m * 16);
                    f32x4 p0 = acc[ai][0][m][0], p1 = acc[ai][0][m][1]; const f32x4 q0 = acc[ai][1][m][0], q1 = acc[ai][1][m][1];
#pragma unroll
                    for (int e = 0; e < 4; ++e) { p0[e] *= silu_f(q0[e]); p1[e] *= silu_f(q1[e]); }
                    u32x4 w; w.x = cvt_pk_bf16(p0[0], p0[1]); w.y = cvt_pk_bf16(p0[2], p0[3]); w.z = cvt_pk_bf16(p1[0], p1[1]); w.w = cvt_pk_bf16(p1[2], p1[3]);
                    *(u32x4*)(dst + row * ZP) = w; }
        }
    }
};

struct PanelSq {
    float* xbuf;
    unsigned* cnt;
    __device__ __forceinline__ void run(const f32x4 (&v)[2][2][4][2], const Unit& u, int wr, int wc, int fr, int fq, LAS unsigned char* lds, int wid, int lane) const {
        LAS float* P = (LAS float*)lds;
        LAS float* S = (LAS float*)(lds + 4096);
#pragma unroll
        for (int ai = 0; ai < 2; ++ai)
#pragma unroll
            for (int m = 0; m < 4; ++m) {
                float q = 0.f;
#pragma unroll
                for (int bj = 0; bj < 2; ++bj)
#pragma unroll
                    for (int n = 0; n < 2; ++n) { const f32x4 x = v[ai][bj][m][n]; q += (x[0] * x[0] + x[1] * x[1]) + (x[2] * x[2] + x[3] * x[3]); }
                q += __shfl_xor(q, 16); q += __shfl_xor(q, 32);
                if (fq == 0) P[(ai * HALF + wr * 64 + m * 16 + fr) * 4 + wc] = q;
            }
        asm volatile("s_waitcnt lgkmcnt(0)" ::: "memory"); __builtin_amdgcn_s_barrier(); asm volatile("" ::: "memory");
        const int row = wid * 64 + lane;
        if (wid < 4) {
            const float tot = (P[row * 4 + 0] + P[row * 4 + 1]) + (P[row * 4 + 2] + P[row * 4 + 3]);
            __hip_atomic_store(xbuf + (size_t)(u.pm * BM + row) * 4 + u.pn, tot, __ATOMIC_RELAXED, __HIP_MEMORY_SCOPE_AGENT);
        }
        asm volatile("s_waitcnt vmcnt(0)" ::: "memory");
        if (wid < 4 && lane == 0) __hip_atomic_fetch_add(cnt + 64 * u.pm, 1u, __ATOMIC_RELAXED, __HIP_MEMORY_SCOPE_AGENT);
        if (wid == 0) {
            unsigned sp = 0;
            while ((unsigned)__builtin_amdgcn_readfirstlane(__hip_atomic_load(cnt + 64 * u.pm, __ATOMIC_RELAXED, __HIP_MEMORY_SCOPE_AGENT)) < 16u) { __builtin_amdgcn_s_sleep(2); if (++sp > (1u << 22)) break; }
            __builtin_amdgcn_fence(__ATOMIC_ACQUIRE, "agent");
        }
        asm volatile("s_waitcnt vmcnt(0) lgkmcnt(0)" ::: "memory"); __builtin_amdgcn_s_barrier(); asm volatile("" ::: "memory");
        if (wid < 4) {
            const float* slot = xbuf + (size_t)(u.pm * BM + row) * 4;
            const float a0 = __hip_atomic_load(slot + 0, __ATOMIC_RELAXED, __HIP_MEMORY_SCOPE_AGENT), a1 = __hip_atomic_load(slot + 1, __ATOMIC_RELAXED, __HIP_MEMORY_SCOPE_AGENT);
            const float a2 = __hip_atomic_load(slot + 2, __ATOMIC_RELAXED, __HIP_MEMORY_SCOPE_AGENT), a3 = __hip_atomic_load(slot + 3, __ATOMIC_RELAXED, __HIP_MEMORY_SCOPE_AGENT);
            S[row] = rsqrtf(((a0 + a1) + (a2 + a3)) * (1.f / 1024.f) + 1e-6f);
        }
        asm volatile("s_waitcnt lgkmcnt(0)" ::: "memory"); __builtin_amdgcn_s_barrier(); asm volatile("" ::: "memory");
    }
};
template <bool WRITE_X  >
struct EpiResNorm {
    static constexpr bool PERM = true, AFTER_DRAIN = true, HAS_INIT = true; static constexpr int NSTORES = 0;
    const float* base; const bf16_t* base16; bf16_t* xout; bf16_t* xn; float* nout; const float* g; PanelSq st;
    __device__ __forceinline__ void init(f32x4 (&acc)[2][2][4][2], const Unit& u, int wr, int wc, int fr, int fq) const {
        const int col0 = u.pn * BM + wc * 32 + 8 * fq;
#pragma unroll
        for (int ai = 0; ai < 2; ++ai)
#pragma unroll
            for (int m = 0; m < 4; ++m) { const size_t off = (size_t)(u.pm * BM + ai * HALF + wr * 64 + m * 16 + fr) * 1024 + col0;
#pragma unroll
                for (int bj = 0; bj < 2; ++bj) {
                    if (WRITE_X) { acc[ai][bj][m][0] = *(const f32x4*)(base + off + bj * HALF); acc[ai][bj][m][1] = *(const f32x4*)(base + off + bj * HALF + 4); }
                    else { const u32x4 b4 = *(const u32x4*)(base16 + a_off(1024, u.pm * BM + ai * HALF + wr * 64 + m * 16 + fr, col0 + bj * HALF));
                        acc[ai][bj][m][0] = (f32x4){bf_lo(b4.x), bf_hi(b4.x), bf_lo(b4.y), bf_hi(b4.y)}; acc[ai][bj][m][1] = (f32x4){bf_lo(b4.z), bf_hi(b4.z), bf_lo(b4.w), bf_hi(b4.w)}; } } }
    }
    __device__ __forceinline__ void fused(f32x4 (&acc)[2][2][4][2], const Unit& u, int wr, int wc, int fr, int fq, LAS unsigned char* lds, int wid, int lane) const {
        const int col0 = u.pn * BM + wc * 32 + 8 * fq;
        st.run(acc, u, wr, wc, fr, fq, lds, wid, lane);
        const LAS float* S = (const LAS float*)(lds + 4096);
        f32x4 gv[2][2];
#pragma unroll
        for (int bj = 0; bj < 2; ++bj)
#pragma unroll
            for (int n = 0; n < 2; ++n) gv[bj][n] = *(const f32x4*)(g + col0 + bj * HALF + n * 4);
#pragma unroll
        for (int ai = 0; ai < 2; ++ai)
#pragma unroll
            for (int m = 0; m < 4; ++m) { const int r = ai * HALF + wr * 64 + m * 16 + fr; const float rstd = S[r]; const size_t off = (size_t)(u.pm * BM + r) * 1024 + col0;
#pragma unroll
                for (int bj = 0; bj < 2; ++bj) { const f32x4 x0 = acc[ai][bj][m][0], x1 = acc[ai][bj][m][1]; const f32x4 y0 = x0 * rstd * gv[bj][0], y1 = x1 * rstd * gv[bj][1];
                    if (WRITE_X) { u32x4 xw; xw.x = cvt_pk_bf16(x0[0], x0[1]); xw.y = cvt_pk_bf16(x0[2], x0[3]); xw.z = cvt_pk_bf16(x1[0], x1[1]); xw.w = cvt_pk_bf16(x1[2], x1[3]); *(u32x4*)(xout + a_off(1024, u.pm * BM + r, col0 + bj * HALF)) = xw;
                        u32x4 w; w.x = cvt_pk_bf16(y0[0], y0[1]); w.y = cvt_pk_bf16(y0[2], y0[3]); w.z = cvt_pk_bf16(y1[0], y1[1]); w.w = cvt_pk_bf16(y1[2], y1[3]); *(u32x4*)(xn + a_off(1024, u.pm * BM + r, col0 + bj * HALF)) = w; }
                    else { *(f32x4*)(nout + off + bj * HALF) = y0; *(f32x4*)(nout + off + bj * HALF + 4) = y1; } } }
    }
};

template <class Epi, class Sched, class Pend>
__device__ __forceinline__ void gemm_phase(LAS unsigned char* lds, const Gemm g, const Sched& S, const Epi& E, const Pend& pend) {
    int tid = threadIdx.x; asm volatile("" : "+v"(tid));
    const int wid = __builtin_amdgcn_readfirstlane(tid >> 6), lane = tid & 63, wr = wid >> 2, wc = wid & 3, fr = lane & 15, fq = lane >> 4;
    const int K = g.K, nt = K / BK;
    unsigned voffA[2], voffB[2];
#pragma unroll
    for (int i = 0; i < 2; ++i) { int R, C; stage_rc(tid * 16 + i * 8192, R, C); const int Rb = Epi::PERM ? ((R & ~31) + perm32(R & 31)) : R;
        voffA[i] = (unsigned)(tid * 16 + i * 8192); voffB[i] = (unsigned)(tid * 16 + i * 8192); (void)Rb; (void)R; (void)C; }
    const size_t kstep = (size_t)HTB;
    const size_t kstepB = (size_t)HTB;
    const size_t hstep = (size_t)HALF * K * 2;
    const size_t tstep = 2 * hstep;
    const unsigned ldsw = (unsigned)wid * 1024u;
    const int aoff = lds_byte(wr * 64 + fr, fq * 8), boff = lds_byte(wc * 32 + fr, fq * 8);
#define PG8_SA(b, h) (((b) * 2 + (h)) * HTB)
#define PG8_SB(b, h) ((4 + (b) * 2 + (h)) * HTB)
#define PG8_STAGE(bufoff, gbase, voff) do { _Pragma("unroll") for (int _i = 0; _i < 2; ++_i) \
        __builtin_amdgcn_global_load_lds((const unsigned*)((const char*)(gbase) + (voff)[_i]), (LAS unsigned*)(lds + (bufoff) + ldsw + _i * 8192), 16, 0, 0); } while (0)
#define PG8_LDA(dst, b, h) do { _Pragma("unroll") for (int m = 0; m < 4; ++m) _Pragma("unroll") for (int k = 0; k < 2; ++k) dst[m][k] = *(const LAS bf16x8*)(lds + PG8_SA(b, h) + aoff + m * 2048 + k * 1024); } while (0)
#define PG8_LDB(dst, b, h) do { _Pragma("unroll") for (int n = 0; n < 2; ++n) _Pragma("unroll") for (int k = 0; k < 2; ++k) dst[n][k] = *(const LAS bf16x8*)(lds + PG8_SB(b, h) + boff + n * 2048 + k * 1024); } while (0)
#define PG8_MMA(ai, bj, At, Bt) do { __builtin_amdgcn_s_setprio(1); _Pragma("unroll") for (int m = 0; m < 4; ++m) _Pragma("unroll") for (int n = 0; n < 2; ++n) _Pragma("unroll") for (int k = 0; k < 2; ++k) \
        acc[ai][bj][m][n] = __builtin_amdgcn_mfma_f32_16x16x32_bf16(Bt[n][k], At[m][k], acc[ai][bj][m][n], 0, 0, 0); __builtin_amdgcn_s_setprio(0); } while (0)
#define PG8_WAIT_V(n) asm volatile("s_waitcnt vmcnt(" #n ")" ::: "memory")
#define PG8_WAIT_L(n) asm volatile("s_waitcnt lgkmcnt(" #n ")" ::: "memory")
#define PG8_BAR __builtin_amdgcn_s_barrier()
#define PG8_SCHED __builtin_amdgcn_sched_barrier(0)
    Unit cur, nxt; int ui = 0;
    if (!S.next(0, cur)) return;
    f32x4 acc[2][2][4][2];
    if constexpr (Epi::HAS_INIT) E.init(acc, cur, wr, wc, fr, fq);
    else {
#pragma unroll
        for (int a = 0; a < 2; ++a)
#pragma unroll
            for (int b = 0; b < 2; ++b)
#pragma unroll
                for (int m = 0; m < 4; ++m)
#pragma unroll
                    for (int n = 0; n < 2; ++n) acc[a][b][m][n] = (f32x4){0.f, 0.f, 0.f, 0.f};
    }
    pend.early();
    bf16x8 At[4][2], B0[2][2], B1[2][2];
    const char* cA = (const char*)g.A + (size_t)cur.pm * tstep; const char* cB = (const char*)g.Bt + (size_t)cur.pn * tstep;
    PG8_STAGE(PG8_SB(0, 0), cB, voffB); PG8_STAGE(PG8_SB(0, 1), cB + hstep, voffB); PG8_STAGE(PG8_SA(0, 0), cA, voffA); PG8_STAGE(PG8_SA(0, 1), cA + hstep, voffA);
    if (wr == 1) PG8_BAR;
    PG8_WAIT_V(2); PG8_BAR;
    PG8_STAGE(PG8_SB(1, 0), cB + kstepB, voffB); PG8_STAGE(PG8_SA(1, 0), cA + kstep, voffA); PG8_STAGE(PG8_SB(1, 1), cB + hstep + kstepB, voffB);
    PG8_WAIT_V(6); PG8_BAR;
    for (;;) {
        const bool has_next = S.next(ui + 1, nxt);
        const char* nA = has_next ? (const char*)g.A + (size_t)nxt.pm * tstep : cA; const char* nB = has_next ? (const char*)g.Bt + (size_t)nxt.pn * tstep : cB;
        for (int t = 0; t < nt; t += 2) {
            const bool last = (t == nt - 2);
            const char* a1 = cA + (size_t)(t + 1) * kstep;
            const char* a2 = last ? nA : cA + (size_t)(t + 2) * kstep; const char* b2 = last ? nB : cB + (size_t)(t + 2) * kstepB;
            const char* a3 = a2 + kstep; const char* b3 = b2 + kstepB;
            PG8_LDB(B0, 0, 0); PG8_LDB(B1, 0, 1); PG8_SCHED; PG8_LDA(At, 0, 0); PG8_STAGE(PG8_SA(1, 1), a1 + hstep, voffA);
            PG8_WAIT_V(8); PG8_WAIT_L(0); PG8_BAR; PG8_MMA(0, 0, At, B0); PG8_MMA(0, 1, At, B1); PG8_BAR; PG8_SCHED;
            PG8_LDA(At, 0, 1); PG8_STAGE(PG8_SB(0, 0), b2, voffB); PG8_STAGE(PG8_SB(0, 1), b2 + hstep, voffB); PG8_STAGE(PG8_SA(0, 0), a2, voffA);
            PG8_WAIT_V(8); PG8_WAIT_L(0); PG8_BAR; PG8_MMA(1, 0, At, B0); PG8_MMA(1, 1, At, B1); PG8_BAR; PG8_SCHED;
            PG8_LDB(B0, 1, 0); PG8_LDB(B1, 1, 1); PG8_SCHED; PG8_LDA(At, 1, 0); PG8_STAGE(PG8_SA(0, 1), a2 + hstep, voffA);
            PG8_WAIT_V(8); PG8_WAIT_L(0); PG8_BAR; PG8_MMA(0, 0, At, B0); PG8_MMA(0, 1, At, B1); PG8_BAR; PG8_SCHED;
            PG8_LDA(At, 1, 1); PG8_STAGE(PG8_SB(1, 0), b3, voffB); PG8_STAGE(PG8_SB(1, 1), b3 + hstep, voffB); PG8_STAGE(PG8_SA(1, 0), a3, voffA);
            PG8_WAIT_V(8); PG8_WAIT_L(0); PG8_BAR; PG8_MMA(1, 0, At, B0); PG8_MMA(1, 1, At, B1); PG8_BAR; PG8_SCHED;
        }
        if (wr == 0) PG8_BAR;
        if (ui == 0) pend.wait();
        if constexpr (!Epi::AFTER_DRAIN) E(acc, cur, wr, wc, fr, fq);
        if (!has_next) break;
#pragma unroll
        for (int a = 0; a < 2; ++a)
#pragma unroll
            for (int b = 0; b < 2; ++b)
#pragma unroll
                for (int m = 0; m < 4; ++m)
#pragma unroll
                    for (int n = 0; n < 2; ++n) acc[a][b][m][n] = (f32x4){0.f, 0.f, 0.f, 0.f};
        cur = nxt; cA = nA; cB = nB; ++ui;
        if (wr == 1) PG8_BAR;
    }
    PG8_WAIT_V(0);
    PG8_BAR;
    if constexpr (Epi::AFTER_DRAIN) E.fused(acc, cur, wr, wc, fr, fq, lds, wid, lane);
#undef PG8_SA
#undef PG8_SB
#undef PG8_STAGE
#undef PG8_LDA
#undef PG8_LDB
#undef PG8_MMA
#undef PG8_WAIT_V
#undef PG8_WAIT_L
#undef PG8_BAR
#undef PG8_SCHED
}
}


#define XB_TMO      128
#define XB_XCNT(j)  (256  + 64 * (j))
#define XB_XSUB(j)  (1280 + 64 * (j))
#define XB_XGEN(j)  (2304 + 64 * (j))
#define XB_TOP      3328
#define XB_TOPGEN   3392
#define XCD_BAR_WORDS 3456
#define XB_SPIN_CAP (1u << 22)
__device__ __forceinline__ unsigned xb_ld(unsigned* p)              { return __hip_atomic_load(p, __ATOMIC_RELAXED, __HIP_MEMORY_SCOPE_AGENT); }
__device__ __forceinline__ unsigned xb_add(unsigned* p, unsigned v) { return __hip_atomic_fetch_add(p, v, __ATOMIC_RELAXED, __HIP_MEMORY_SCOPE_AGENT); }
__device__ __forceinline__ unsigned xb_xcc_id() { return (unsigned)__builtin_amdgcn_s_getreg((3 << 11) | 20) & 0xFu; }
#define XB_SPIN(cond, bar) do { unsigned _sp = 0; while (cond) { __builtin_amdgcn_s_sleep(1); \
    if ((++_sp & 255u) == 0u) { if (xb_ld(&(bar)[XB_TMO])) break; if (_sp > XB_SPIN_CAP) { atomicAdd(&(bar)[XB_TMO], 1u); break; } } } } while (0)
struct XcdBarrier { unsigned* bar; unsigned x; volatile LAS unsigned* st; };
__device__ __forceinline__ XcdBarrier xcd_barrier_post(unsigned* bar, volatile LAS unsigned* st) {
    XcdBarrier b; b.bar = bar; b.x = xb_xcc_id(); b.st = st;
    if (threadIdx.x == 0) (void)xb_add(&bar[XB_XCNT(b.x)], 1u);
    return b;
}
__device__ __forceinline__ void xcd_barrier_complete(unsigned* bar, unsigned x, unsigned& nloc, unsigned& nx) {
    const unsigned G = gridDim.x * gridDim.y * gridDim.z;
    unsigned sum, cnt, mine, sp = 0u;
    for (;;) {
        sum = 0u; cnt = 0u; mine = 0u;
#pragma unroll
        for (unsigned j = 0; j < 16; ++j) { const unsigned c = xb_ld(&bar[XB_XCNT(j)]); sum += c; cnt += (c > 0u) ? 1u : 0u; mine = (j == x) ? c : mine; }
        if (sum == G) break;
        __builtin_amdgcn_s_sleep(1);
        if ((++sp & 255u) == 0u) { if (xb_ld(&bar[XB_TMO])) break; if (sp > XB_SPIN_CAP) { atomicAdd(&bar[XB_TMO], 1u); break; } }
    }
    nloc = mine > 0u ? mine : 1u; nx = cnt > 0u ? cnt : 1u;
}
__device__ __forceinline__ void xcd_arrive(const XcdBarrier& b) {
    asm volatile("s_waitcnt vmcnt(0)" ::: "memory");
    __syncthreads();
    if (threadIdx.x == 0) {
        unsigned* bar = b.bar;
        __builtin_amdgcn_s_waitcnt(0);
        unsigned nloc = b.st[0], nx = b.st[1];
        if (nloc == 0u) { xcd_barrier_complete(bar, b.x, nloc, nx); b.st[0] = nloc; b.st[1] = nx; }
        const unsigned old = xb_add(&bar[XB_XSUB(b.x)], 1u);
        const unsigned gen = old / nloc;
        if (old + 1u == (gen + 1u) * nloc) {
            __builtin_amdgcn_fence(__ATOMIC_RELEASE, "agent");
            asm volatile("s_waitcnt vmcnt(0)" ::: "memory");
            (void)xb_add(&bar[XB_TOP], 1u);
        }
        b.st[2] = (gen + 1u) * nx;
    }
}
__device__ __forceinline__ void xcd_wait(const XcdBarrier& b) {
    if (threadIdx.x == 0) {
        unsigned* bar = b.bar; const unsigned want = b.st[2];
        XB_SPIN(xb_ld(&bar[XB_TOP]) < want, bar);
        __builtin_amdgcn_fence(__ATOMIC_ACQUIRE, "agent");
        asm volatile("s_waitcnt vmcnt(0)" ::: "memory");
    }
    __syncthreads();
}
__device__ __forceinline__ void xcd_barrier(const XcdBarrier& b) { xcd_arrive(b); xcd_wait(b); }
struct NoPend    { __device__ __forceinline__ void early() const {} __device__ __forceinline__ void wait() const {} };
struct BarPend   { const XcdBarrier* b; __device__ __forceinline__ void early() const {} __device__ __forceinline__ void wait() const { xcd_wait(*b); } };
struct EarlyPend { const XcdBarrier* b; __device__ __forceinline__ void early() const { xcd_wait(*b); } __device__ __forceinline__ void wait() const {} };
constexpr size_t WS_BAR = WS_LSE + 512 * 1024, WS_CNT0 = WS_BAR + 16384, WS_CNT1 = WS_BAR + 32768, WS_XB0 = WS_LSE + 768 * 1024, WS_XB1 = WS_WSB + 256 * 1024;
constexpr int MISC_OFF = LDS_BYTES - 128;

struct Args {
    const float* x; const float* even_norm; const float* even_w_in; const float* even_pool_w; const float* even_pool_scale; const float* even_ws; const float* even_bs;
    const float* even_w_out; const float* odd_norm; const float* odd_w_in; const float* odd_conv_w; const float* odd_w_out; const float* final_norm;
    float* out; unsigned char* ws; int ph_lo, ph_hi;
};

__device__ __forceinline__ size_t wt_off(int K, int n, int k) {
    const int nl = n & 127, x = nl & 31, rho = 16 * ((x >> 2) & 1) + 4 * (x >> 3) + (x & 3);
    const int R = (nl & ~31) + rho;
    return ((size_t)(n >> 7) * (K >> 6) + (k >> 6)) * (pg8::HTB / 2) + (size_t)(pg8::lds_byte(R, k & 63) >> 1);
}
struct TItem { const float* W; bf16_t* WT; int N, K, k0, nsrc0, ndst0; };
__device__ __forceinline__ void titem_load(const TItem& t, f32x4 (&v)[8], int lane) {
#pragma unroll
    for (int i = 0; i < 8; ++i) v[i] = *(const f32x4*)(t.W + (size_t)(t.k0 + 8 * i + (lane >> 3)) * t.N + t.nsrc0 + 4 * (lane & 7));
}
__device__ __forceinline__ void titem_finish(const TItem& t, const f32x4 (&v)[8], LAS float* scr, int lane) {
#pragma unroll
    for (int i = 0; i < 8; ++i) { LAS float* d = scr + (8 * i + (lane >> 3)) * 33 + 4 * (lane & 7); d[0] = v[i][0]; d[1] = v[i][1]; d[2] = v[i][2]; d[3] = v[i][3]; }
    asm volatile("s_waitcnt lgkmcnt(0)" ::: "memory");
    const int c = lane & 7;
#pragma unroll
    for (int j = 0; j < 4; ++j) { const int n = (lane >> 3) + 8 * j; const LAS float* sp = scr + (8 * c) * 33 + n;
        u32x4 o; o.x = cvt_pk_bf16(sp[0 * 33], sp[1 * 33]); o.y = cvt_pk_bf16(sp[2 * 33], sp[3 * 33]); o.z = cvt_pk_bf16(sp[4 * 33], sp[5 * 33]); o.w = cvt_pk_bf16(sp[6 * 33], sp[7 * 33]);
        *(u32x4*)(t.WT + wt_off(t.K, t.ndst0 + n, t.k0 + 8 * c)) = o; }
    asm volatile("s_waitcnt lgkmcnt(0)" ::: "memory");
}
__device__ __forceinline__ int w1_dst_row(int n) {
    if (n < 2048) return n;
    if (n < 3072) { const int ch = n - 2048; return 3072 + (ch / 128) * 256 + ch % 128; }
    if (n < 4096) return n - 1024;
    { const int ch = n - 4096; return 3072 + (ch / 128) * 256 + 128 + ch % 128; }
}
__device__ __forceinline__ int w3_dst_row(int n) {
    if (n < 9216) { const int which = n / 3072, rem = n % 3072, gi = rem / 1024, j = rem % 1024; return gi * 3072 + which * 1024 + j; }
    if (n < 10240) return n + 2048;
    const int rel = n - 10240, type = rel / 1024, ch = rel % 1024, t128 = ch / 128, within = ch % 128;
    if (type == 1 || type == 2) return 9216 + t128 * 256 + (type == 1 ? 0 : 128) + within;
    return 12288 + t128 * 256 + (type == 0 ? 0 : 128) + within;
}
__device__ __forceinline__ TItem w3_item(const float* W, bf16_t* W3T, int col0, int nb, int idx) { const int kb = idx / nb, nbk = idx % nb, src = col0 + nbk * 32; return TItem{W, W3T, ODD_IN, DM, kb * 64, src, w3_dst_row(src)}; }
__device__ __forceinline__ TItem wo_item(const float* W, bf16_t* WT, int idx) { const int kb = idx / 32, nbk = idx % 32; return TItem{W, WT, DM, DI, kb * 64, nbk * 32, nbk * 32}; }
__device__ __forceinline__ TItem qkv_item(const float* W, bf16_t* W3T, int gi, int r) { const int which = r / 512; return w3_item(W, W3T, which * 3072 + gi * 1024, 32, r % 512); }
template <int SEAM>
__device__ __forceinline__ void seam_convert(const float* w_out_even, const float* w_in_odd, const float* w_out_odd, bf16_t* W2T, bf16_t* W3T, bf16_t* W4T, LAS float* scr, int gw, int NGW, int lane) {
    constexpr int total = (SEAM == 1) ? 2048 : (SEAM == 2) ? 1536 : (SEAM == 3) ? 2048 : (SEAM == 4) ? 2048 : 1536;
    for (int i = gw; i < total; i += NGW) {
        TItem T;
        if (SEAM == 1) { if (i < 1024) T = wo_item(w_out_even, W2T, i); else T = qkv_item(w_in_odd, W3T, 0, i - 1024); }
        else if (SEAM == 2) { if (i < 512) T = qkv_item(w_in_odd, W3T, 0, 1024 + i); else T = wo_item(w_out_odd, W4T, i - 512); }
        else if (SEAM == 3) { if (i < 1536) T = qkv_item(w_in_odd, W3T, 1, i); else T = w3_item(w_in_odd, W3T, 11264, 64, i - 1536); }
        else if (SEAM == 4) { if (i < 1536) T = qkv_item(w_in_odd, W3T, 2, i); else T = w3_item(w_in_odd, W3T, 11264, 64, 512 + (i - 1536)); }
        else { if (i < 512) T = w3_item(w_in_odd, W3T, 9216, 32, i); else if (i < 1024) T = w3_item(w_in_odd, W3T, 10240, 32, i - 512); else T = w3_item(w_in_odd, W3T, 13312, 32, i - 1024); }
        f32x4 v[8]; titem_load(T, v, lane); titem_finish(T, v, scr, lane);
    }
}
__device__ __forceinline__ void rms_row_bf16(const float* xrow, const float* g, bf16_t* orow, int lane) {
    const f32x4* xr = (const f32x4*)xrow + lane; const f32x4* gr = (const f32x4*)g + lane;
    f32x4 v[4]; float s = 0.f;
#pragma unroll
    for (int j = 0; j < 4; ++j) { v[j] = xr[64 * j]; s += (v[j].x * v[j].x + v[j].y * v[j].y) + (v[j].z * v[j].z + v[j].w * v[j].w); }
    const float rstd = rsqrtf(wave_sum(s) * (1.f / DM) + EPS);
    u32x2* o8 = (u32x2*)orow + lane;
#pragma unroll
    for (int j = 0; j < 4; ++j) { const f32x4 gg = gr[64 * j]; u32x2 w; w.x = cvt_pk_bf16(v[j].x * rstd * gg.x, v[j].y * rstd * gg.y); w.y = cvt_pk_bf16(v[j].z * rstd * gg.z, v[j].w * rstd * gg.w); o8[64 * j] = w; }
}
__device__ __forceinline__ void rms_row2_bf16(const float* xa, const float* xb, const float* g, bf16_t* XNt  , int ma, int mb, int lane) {
    const f32x4* pa = (const f32x4*)xa + lane; const f32x4* pb = (const f32x4*)xb + lane; const f32x4* gr = (const f32x4*)g + lane;
    f32x4 va[4], vb[4]; float sa = 0.f, sb = 0.f;
#pragma unroll
    for (int j = 0; j < 4; ++j) { va[j] = pa[64 * j]; vb[j] = pb[64 * j]; }
#pragma unroll
    for (int j = 0; j < 4; ++j) { sa += (va[j].x * va[j].x + va[j].y * va[j].y) + (va[j].z * va[j].z + va[j].w * va[j].w); sb += (vb[j].x * vb[j].x + vb[j].y * vb[j].y) + (vb[j].z * vb[j].z + vb[j].w * vb[j].w); }
    const float ra = rsqrtf(wave_sum(sa) * (1.f / DM) + EPS), rb = rsqrtf(wave_sum(sb) * (1.f / DM) + EPS);
#pragma unroll
    for (int j = 0; j < 4; ++j) { const f32x4 gg = gr[64 * j]; u32x2 w;
        w.x = cvt_pk_bf16(va[j].x * ra * gg.x, va[j].y * ra * gg.y); w.y = cvt_pk_bf16(va[j].z * ra * gg.z, va[j].w * ra * gg.w); *(u32x2*)(XNt + pg8::a_off(DM, ma, (64 * j + lane) * 4)) = w;
        w.x = cvt_pk_bf16(vb[j].x * rb * gg.x, vb[j].y * rb * gg.y); w.y = cvt_pk_bf16(vb[j].z * rb * gg.z, vb[j].w * rb * gg.w); *(u32x2*)(XNt + pg8::a_off(DM, mb, (64 * j + lane) * 4)) = w; }
}
__device__ __forceinline__ void fold_item(const float* Win, const float* PW, bf16_t* W1T, LAS float* sm, int item, int tid) {
    LAS float* As = sm;
    LAS float* Bs = sm + 64 * 33;
    const int k0 = (item >> 4) * 64, n0 = (item & 15) * 64, g = n0 >> 8, d0 = n0 & 255;
    const int tk = tid >> 4, tn = tid & 15;
    float acc[2][4];
#pragma unroll
    for (int i = 0; i < 2; ++i)
#pragma unroll
        for (int j = 0; j < 4; ++j) acc[i][j] = 0.f;
    float ra[4], rb[4];
#pragma unroll
    for (int i = 0; i < 4; ++i) { const int idx = tid + 512 * i; ra[i] = Win[(size_t)(k0 + (idx >> 5)) * EVEN_IN + g * 256 + (idx & 31)]; rb[i] = PW[((size_t)(g * 256 + (idx >> 6))) * 256 + d0 + (idx & 63)]; }
    for (int c0 = 0; c0 < 256; c0 += 32) {
        __syncthreads();
#pragma unroll
        for (int i = 0; i < 4; ++i) { const int idx = tid + 512 * i; As[(idx >> 5) * 33 + (idx & 31)] = ra[i]; Bs[(idx >> 6) * 64 + (idx & 63)] = rb[i]; }
        __syncthreads();
        if (c0 + 32 < 256) {
#pragma unroll
            for (int i = 0; i < 4; ++i) { const int idx = tid + 512 * i; ra[i] = Win[(size_t)(k0 + (idx >> 5)) * EVEN_IN + g * 256 + c0 + 32 + (idx & 31)]; rb[i] = PW[((size_t)(g * 256 + c0 + 32 + (idx >> 6))) * 256 + d0 + (idx & 63)]; }
        }
#pragma unroll 8
        for (int c = 0; c < 32; ++c) { const float a0 = As[(2 * tk) * 33 + c], a1 = As[(2 * tk + 1) * 33 + c]; const f32x4 b = *(const LAS f32x4*)(Bs + c * 64 + 4 * tn);
#pragma unroll
            for (int j = 0; j < 4; ++j) { acc[0][j] += a0 * b[j]; acc[1][j] += a1 * b[j]; } }
    }
#pragma unroll
    for (int j = 0; j < 4; ++j) *(unsigned*)(W1T + wt_off(DM, n0 + 4 * tn + j, k0 + 2 * tk)) = cvt_pk_bf16(acc[0][j], acc[1][j]);
}

__device__ __forceinline__ void unpack8(const u32x4 v, float (&f)[8]) { f[0] = bf_lo(v.x); f[1] = bf_hi(v.x); f[2] = bf_lo(v.y); f[3] = bf_hi(v.y); f[4] = bf_lo(v.z); f[5] = bf_hi(v.z); f[6] = bf_lo(v.w); f[7] = bf_hi(v.w); }
template <int W>
__device__ __forceinline__ void ya_run(const bf16_t* Z1, const float* scale, bf16_t* Y1, int t0, int oc) {
    const int tl0 = t0 & (SEQ - 1);
    constexpr int RUN = 8;
    u32x4 R[W + RUN - 1];
#pragma unroll
    for (int k = 0; k < W + RUN - 1; ++k) { const int dt = k - (W - 1); R[k] = (tl0 + dt >= 0) ? *(const u32x4*)(Z1 + (size_t)(t0 + dt) * ZP + oc * 8) : (u32x4){0u, 0u, 0u, 0u}; }
    const f32x4 sc0 = *(const f32x4*)(scale + oc * 8), sc1 = *(const f32x4*)(scale + oc * 8 + 4);
    const float sc[8] = {sc0[0], sc0[1], sc0[2], sc0[3], sc1[0], sc1[1], sc1[2], sc1[3]};
    float s[8];
#pragma unroll
    for (int e = 0; e < 8; ++e) s[e] = 0.f;
#pragma unroll
    for (int k = 0; k < W - 1; ++k) { float f[8]; unpack8(R[k], f);
#pragma unroll
        for (int e = 0; e < 8; ++e) s[e] += f[e]; }
    u32x4 GA[RUN];
#pragma unroll
    for (int i = 0; i < RUN; ++i) GA[i] = *(const u32x4*)(Z1 + (size_t)(t0 + i) * ZP + 1024 + oc * 8);
#pragma unroll
    for (int i = 0; i < RUN; ++i) {
        float cur[8]; unpack8(R[i + W - 1], cur);
#pragma unroll
        for (int e = 0; e < 8; ++e) s[e] += cur[e];
        if (i > 0) { u32x4 tmp = R[i - 1]; asm volatile("" : "+v"(tmp)); float old[8]; unpack8(tmp, old);
#pragma unroll
            for (int e = 0; e < 8; ++e) s[e] -= old[e]; }
        const int tl = tl0 + i; const float inv = 1.0f / (float)((tl + 1 < W) ? tl + 1 : W);
        float gg[8]; unpack8(GA[i], gg);
        float o[8];
#pragma unroll
        for (int e = 0; e < 8; ++e) o[e] = (s[e] * inv - cur[e]) * sc[e] * gg[e];
        u32x4 w4; w4.x = cvt_pk_bf16(o[0], o[1]); w4.y = cvt_pk_bf16(o[2], o[3]); w4.z = cvt_pk_bf16(o[4], o[5]); w4.w = cvt_pk_bf16(o[6], o[7]);
        *(u32x4*)(Y1 + pg8::a_off(DI, t0 + i, oc * 8)) = w4;
    }
}
__device__ __forceinline__ void ya_phase(const bf16_t* Z1, const float* scale, bf16_t* Y1, int gw, int NGW, int lane) {
    for (int it = gw; it < 4 * 1024; it += NGW) {
        const int g = it & 3, rp = it >> 2;
        const int t0 = (rp * 2 + (lane >> 5)) * 8, oc = g * 32 + (lane & 31);
        if (g == 0) ya_run<2>(Z1, scale, Y1, t0, oc); else if (g == 1) ya_run<4>(Z1, scale, Y1, t0, oc); else if (g == 2) ya_run<8>(Z1, scale, Y1, t0, oc); else ya_run<16>(Z1, scale, Y1, t0, oc);
    }
}
constexpr int VB_STRIDE = 544;
__device__ __forceinline__ void yb_phase(LAS unsigned char* lds, const bf16_t* Z1, const bf16_t* WSB, const float* bs, bf16_t* Y1, int G, int bid) {
    int tid = threadIdx.x; asm volatile("" : "+v"(tid));
    const int lane = tid & 63, w = __builtin_amdgcn_readfirstlane(tid >> 6), ql = lane & 15, gq = lane >> 4;
    for (int unit = bid; unit < 512; unit += G) {
        const int ck = unit >> 2, g = unit & 3, row0 = ck * 128;
        __syncthreads();
#pragma unroll
        for (int i = 0; i < 8; ++i) { const int idx = tid + 512 * i, rr = idx >> 5, ch = idx & 31;
            const u32x4 val = *(const u32x4*)(Z1 + (size_t)(row0 + rr) * ZP + 2048 + 256 * g + ch * 8);
            *(LAS u32x4*)(lds + rr * VB_STRIDE + ch * 16) = val; }
        __syncthreads();
        const int t = 16 * w + ql;
        bf16x8 wf[4];
#pragma unroll
        for (int ks = 0; ks < 4; ++ks) wf[ks] = *(const bf16x8*)(WSB + (size_t)(g * 128 + t) * 128 + 32 * ks + 8 * gq);
        const int nks = (w >> 1) + 1;
        const size_t rowg = (size_t)(row0 + t);
        const float bias = bs[g * 128 + t];
        const LAS unsigned char* vbase = lds + (8 * gq + (ql >> 2)) * VB_STRIDE + (ql & 3) * 8;
        u32x2 ua[16];
#pragma unroll
        for (int cb = 0; cb < 16; ++cb) { const int c0 = 256 * g + 16 * cb + 4 * gq; ua[cb] = *(const u32x2*)(Z1 + rowg * ZP + 3072 + c0); }
#pragma unroll
        for (int cb = 0; cb < 16; ++cb) {
            f32x4 acc = {0.f, 0.f, 0.f, 0.f};
#pragma unroll
            for (int ks = 0; ks < 4; ++ks) {
                if (ks < nks) {
                    const LAS unsigned char* p = vbase + ks * 32 * VB_STRIDE + cb * 32;
                    const s16x4 lo = tr_read(p), hi = tr_read(p + 4 * VB_STRIDE);
                    acc = __builtin_amdgcn_mfma_f32_16x16x32_bf16(cat8(lo, hi), wf[ks], acc, 0, 0, 0);
                }
            }
            const int c0 = 256 * g + 16 * cb + 4 * gq;
            const u32x2 u2 = ua[cb];
            const float o0 = bf_lo(u2.x) * (acc[0] + bias), o1 = bf_hi(u2.x) * (acc[1] + bias);
            const float o2 = bf_lo(u2.y) * (acc[2] + bias), o3 = bf_hi(u2.y) * (acc[3] + bias);
            u32x2 o; o.x = cvt_pk_bf16(o0, o1); o.y = cvt_pk_bf16(o2, o3);
            *(u32x2*)(Y1 + pg8::a_off(DI, (int)rowg, 1024 + c0)) = o;
        }
    }
}

constexpr int KV_STRIDE = 272, KV_BLK = 128 * KV_STRIDE, V_STRIDE = 288, V_BLK = 128 * V_STRIDE, V_BASE = 2 * KV_BLK;
template <int gi>
__device__ __forceinline__ void attn_group_phase(LAS unsigned char* lds, const bf16_t* QKV, bf16_t* O, float* LSE, int G, int bid) {
    int tid = threadIdx.x; asm volatile("" : "+v"(tid));
    const int lane = tid & 63, w = __builtin_amdgcn_readfirstlane(tid >> 6), ql = lane & 15, gq = lane >> 4;
    constexpr int dil = (gi == 0) ? 1 : (gi == 1) ? 4 : 16, nb = 64 / dil, rps = nb / 4;
    for (int job = bid; job < 256; job += G) {
        const int sub = job / rps, n0 = (job % rps) * 4;
        const int r = sub % dil, h = (sub / dil) & 7, b = sub / (dil * 8);
        const float slope = exp2f(-8.0f * (float)(gi * 8 + h + 1) / 24.0f);
        const float c1 = 0.08838834764831845f * 1.4426950408889634f, c2 = slope * (float)dil * 1.4426950408889634f;
        const size_t rowb = (size_t)b * SEQ;
        const int lrow = tid >> 4, lch = tid & 15;
        __syncthreads();
        {
            const int sp = (n0 - 1) & 1;
            LAS unsigned char* kd = lds + sp * KV_BLK; LAS unsigned char* vd = lds + V_BASE + sp * V_BLK;
            if (n0 == 0) {
#pragma unroll
                for (int ps = 0; ps < 4; ++ps) { const int rr = lrow + 32 * ps; *(LAS u32x4*)(kd + rr * KV_STRIDE + lch * 16) = (u32x4){0u, 0u, 0u, 0u}; *(LAS u32x4*)(vd + rr * V_STRIDE + lch * 16) = (u32x4){0u, 0u, 0u, 0u}; }
            } else {
                u32x4 tk[4], tv[4];
#pragma unroll
                for (int ps = 0; ps < 4; ++ps) { const int rr = lrow + 32 * ps; const size_t grow = rowb + (size_t)(128 * (n0 - 1) + rr) * dil + r;
                    const bf16_t* src = QKV + grow * 3072 + h * 128 + lch * 8; tk[ps] = *(const u32x4*)(src + 1024); tv[ps] = *(const u32x4*)(src + 2048); }
#pragma unroll
                for (int ps = 0; ps < 4; ++ps) { const int rr = lrow + 32 * ps; *(LAS u32x4*)(kd + rr * KV_STRIDE + lch * 16) = tk[ps]; *(LAS u32x4*)(vd + rr * V_STRIDE + lch * 16) = tv[ps]; }
            }
        }
        u32x4 pk[4], pv[4];
#pragma unroll
        for (int ps = 0; ps < 4; ++ps) { const int rr = lrow + 32 * ps; const size_t grow = rowb + (size_t)(128 * n0 + rr) * dil + r;
            const bf16_t* src = QKV + grow * 3072 + h * 128 + lch * 8; pk[ps] = *(const u32x4*)(src + 1024); pv[ps] = *(const u32x4*)(src + 2048); }
        for (int n = n0; n < n0 + 4; ++n) {
            const size_t growq = rowb + (size_t)(128 * n + 16 * w + ql) * dil + r;
            bf16x8 qf[4];
#pragma unroll
            for (int ks = 0; ks < 4; ++ks) qf[ks] = *(const bf16x8*)(QKV + growq * 3072 + h * 128 + 32 * ks + 8 * gq);
            {
                const int sc = n & 1;
                LAS unsigned char* kd = lds + sc * KV_BLK; LAS unsigned char* vd = lds + V_BASE + sc * V_BLK;
#pragma unroll
                for (int ps = 0; ps < 4; ++ps) { const int rr = lrow + 32 * ps; *(LAS u32x4*)(kd + rr * KV_STRIDE + lch * 16) = pk[ps]; *(LAS u32x4*)(vd + rr * V_STRIDE + lch * 16) = pv[ps]; }
            }
            __syncthreads();
            float* lsep = LSE + growq * 8 + h;
            bf16_t* op = O + growq * 1024 + h * 128 + 4 * gq;
            float lse_prev = 0.f; u32x2 oprev[8];
            if (gi > 0) { lse_prev = *lsep;
#pragma unroll
                for (int db = 0; db < 8; ++db) oprev[db] = *(const u32x2*)(op + 16 * db); }
            if (n + 1 < n0 + 4) {
#pragma unroll
                for (int ps = 0; ps < 4; ++ps) { const int rr = lrow + 32 * ps; const size_t grow = rowb + (size_t)(128 * (n + 1) + rr) * dil + r;
                    const bf16_t* src = QKV + grow * 3072 + h * 128 + lch * 8; pk[ps] = *(const u32x4*)(src + 1024); pv[ps] = *(const u32x4*)(src + 2048); }
            }
            f32x4 S[9];
#pragma unroll
            for (int kb = 0; kb < 9; ++kb) {
                const int kabs = w + kb, slot = (kabs < 8) ? ((n - 1) & 1) : (n & 1);
                const LAS unsigned char* kp = lds + slot * KV_BLK + ((kabs & 7) * 16 + ql) * KV_STRIDE + gq * 16;
                f32x4 acc = {0.f, 0.f, 0.f, 0.f};
#pragma unroll
                for (int ks = 0; ks < 4; ++ks) acc = __builtin_amdgcn_mfma_f32_16x16x32_bf16(*(const LAS bf16x8*)(kp + 64 * ks), qf[ks], acc, 0, 0, 0);
                S[kb] = acc;
            }
            float mx = -1e30f;
#pragma unroll
            for (int kb = 0; kb < 9; ++kb) {
                const bool blk_ok = (n > 0) || (w + kb >= 8);
#pragma unroll
                for (int e = 0; e < 4; ++e) {
                    const int steps = 128 + ql - 16 * kb - 4 * gq - e;
                    const bool ok = blk_ok && steps >= 0 && steps <= 128;
                    const float v = ok ? S[kb][e] * c1 - c2 * (float)steps : -1e30f;
                    S[kb][e] = v; mx = fmaxf(mx, v);
                }
            }
            mx = fmaxf(mx, __shfl_xor(mx, 16)); mx = fmaxf(mx, __shfl_xor(mx, 32));
            float l = 0.f;
#pragma unroll
            for (int kb = 0; kb < 9; ++kb)
#pragma unroll
                for (int e = 0; e < 4; ++e) { const float p = __builtin_amdgcn_exp2f(S[kb][e] - mx); S[kb][e] = p; l += p; }
            l += __shfl_xor(l, 16); l += __shfl_xor(l, 32);
            f32x4 o[8];
#pragma unroll
            for (int db = 0; db < 8; ++db) o[db] = (f32x4){0.f, 0.f, 0.f, 0.f};
#pragma unroll
            for (int p = 0; p < 5; ++p) {
                const int kx = w + 2 * p, ky = (p < 4) ? kx + 1 : kx;
                const f32x4 X = S[2 * p]; const f32x4 Yv = (p < 4) ? S[(p < 4) ? 2 * p + 1 : 0] : (f32x4){0.f, 0.f, 0.f, 0.f};
                u32x4 pw; pw.x = cvt_pk_bf16(X[0], X[1]); pw.y = cvt_pk_bf16(X[2], X[3]); pw.z = cvt_pk_bf16(Yv[0], Yv[1]); pw.w = cvt_pk_bf16(Yv[2], Yv[3]);
                const bf16x8 pf = __builtin_bit_cast(bf16x8, pw);
                const int sx = (kx < 8) ? ((n - 1) & 1) : (n & 1), sy = (ky < 8) ? ((n - 1) & 1) : (n & 1);
                const LAS unsigned char* vx = lds + V_BASE + sx * V_BLK + ((kx & 7) * 16 + 4 * gq + (ql >> 2)) * V_STRIDE + (ql & 3) * 8;
                const LAS unsigned char* vy = lds + V_BASE + sy * V_BLK + ((ky & 7) * 16 + 4 * gq + (ql >> 2)) * V_STRIDE + (ql & 3) * 8;
#pragma unroll
                for (int db = 0; db < 8; ++db) { const s16x4 lo = tr_read(vx + db * 32), hi = tr_read(vy + db * 32);
                    o[db] = __builtin_amdgcn_mfma_f32_16x16x32_bf16(cat8(lo, hi), pf, o[db], 0, 0, 0); }
            }
            const float inv_l = 1.0f / l;
            const float lse_cur = (mx + __builtin_amdgcn_logf(l)) * 0.6931471805599453f;
            float ca = 0.f, cb = inv_l, lse_new = lse_cur;
            if (gi > 0) {
                const float mm = fmaxf(lse_prev, lse_cur);
                const float wp = __expf(lse_prev - mm), wcur = __expf(lse_cur - mm), inv = 1.0f / (wp + wcur);
                ca = wp * inv; cb = wcur * inv * inv_l; lse_new = mm + __logf(wp + wcur);
            }
#pragma unroll
            for (int db = 0; db < 8; ++db) {
                f32x4 v = o[db] * cb;
                if (gi > 0) { const u32x2 pr = oprev[db]; v[0] += ca * bf_lo(pr.x); v[1] += ca * bf_hi(pr.x); v[2] += ca * bf_lo(pr.y); v[3] += ca * bf_hi(pr.y); }
                u32x2 st; st.x = cvt_pk_bf16(v[0], v[1]); st.y = cvt_pk_bf16(v[2], v[3]);
                *(u32x2*)(op + 16 * db) = st;
            }
            if (gq == 0) *lsep = lse_new;
            __syncthreads();
        }
    }
}


template <int gi>
__device__ __forceinline__ void attn_naive_phase(const bf16_t* QKV, bf16_t* O, float* LSE, int gw, int NGW, int lane) {
    constexpr int dil = (gi == 0) ? 1 : (gi == 1) ? 4 : 16;
    for (int it = gw; it < M_TOK * 8; it += NGW) {
        const int row = it >> 3, h = it & 7, tl = row & (SEQ - 1);
        const float slope = exp2f(-8.0f * (float)(gi * 8 + h + 1) / 24.0f) * (float)dil;
        const unsigned qq = *(const unsigned*)(QKV + (size_t)row * 3072 + h * 128 + 2 * lane);
        const float q0 = bf_lo(qq), q1 = bf_hi(qq);
        float m = -1e30f, l = 0.f, o0 = 0.f, o1 = 0.f;
        for (int j = 0; j <= 128; ++j) {
            if (tl - j * dil < 0) break;
            const size_t kr = (size_t)(row - j * dil) * 3072 + h * 128 + 2 * lane;
            const unsigned kk = *(const unsigned*)(QKV + kr + 1024), vv = *(const unsigned*)(QKV + kr + 2048);
            const float d = wave_sum(q0 * bf_lo(kk) + q1 * bf_hi(kk));
            const float sc = d * 0.08838834764831845f - slope * (float)j;
            const float mn = fmaxf(m, sc), f = __expf(m - mn), p = __expf(sc - mn);
            l = l * f + p; o0 = o0 * f + p * bf_lo(vv); o1 = o1 * f + p * bf_hi(vv); m = mn;
        }
        const float inv_l = 1.0f / l; const float lse_cur = m + __logf(l);
        float ca = 0.f, cb = inv_l, lse_new = lse_cur;
        float* lsep = LSE + (size_t)row * 8 + h;
        unsigned* op = (unsigned*)(O + (size_t)row * 1024 + h * 128 + 2 * lane);
        if (gi > 0) {
            const float lse_prev = *lsep; const float mm = fmaxf(lse_prev, lse_cur);
            const float wp = __expf(lse_prev - mm), wcur = __expf(lse_cur - mm), inv = 1.0f / (wp + wcur);
            ca = wp * inv; cb = wcur * inv * inv_l; lse_new = mm + __logf(wp + wcur);
            const unsigned pr = *op; o0 = o0 * cb + ca * bf_lo(pr); o1 = o1 * cb + ca * bf_hi(pr);
        } else { o0 *= cb; o1 *= cb; }
        *op = cvt_pk_bf16(o0, o1);
        if (lane == 0) *lsep = lse_new;
    }
}

__device__ __forceinline__ void conv_phase(const bf16_t* ZC, const bf16_t* GB, const float* cw, bf16_t* Y2, int gtid, int gthreads) {
    for (int it = gtid; it < (M_TOK / 8) * 128; it += gthreads) {
        const int oc = it & 127, t0 = (it >> 7) * 8, tl0 = t0 & (SEQ - 1);
        u32x4 Z[10], Gv[8];
#pragma unroll
        for (int k = 0; k < 10; ++k) Z[k] = (tl0 + k - 2 >= 0) ? *(const u32x4*)(ZC + (size_t)(t0 + k - 2) * 1024 + oc * 8) : (u32x4){0u, 0u, 0u, 0u};
#pragma unroll
        for (int k = 0; k < 8; ++k) Gv[k] = *(const u32x4*)(GB + (size_t)(t0 + k) * 1024 + oc * 8);
        float w0[8], w1[8], w2[8];
        { const f32x4 a0 = *(const f32x4*)(cw + oc * 8), a1 = *(const f32x4*)(cw + oc * 8 + 4), b0 = *(const f32x4*)(cw + 1024 + oc * 8), b1 = *(const f32x4*)(cw + 1024 + oc * 8 + 4),
                      c0 = *(const f32x4*)(cw + 2048 + oc * 8), c1 = *(const f32x4*)(cw + 2048 + oc * 8 + 4);
#pragma unroll
          for (int e = 0; e < 4; ++e) { w0[e] = a0[e]; w0[4 + e] = a1[e]; w1[e] = b0[e]; w1[4 + e] = b1[e]; w2[e] = c0[e]; w2[4 + e] = c1[e]; } }
#pragma unroll
        for (int i = 0; i < 8; ++i) {
            float z2[8], z1[8], z0[8], gg[8], o[8];
            unpack8(Z[i], z2); unpack8(Z[i + 1], z1); unpack8(Z[i + 2], z0); unpack8(Gv[i], gg);
#pragma unroll
            for (int e = 0; e < 8; ++e) o[e] = gg[e] * (w0[e] * z2[e] + w1[e] * z1[e] + w2[e] * z0[e]);
            u32x4 w4; w4.x = cvt_pk_bf16(o[0], o[1]); w4.y = cvt_pk_bf16(o[2], o[3]); w4.z = cvt_pk_bf16(o[4], o[5]); w4.w = cvt_pk_bf16(o[6], o[7]);
            *(u32x4*)(Y2 + (size_t)(t0 + i) * DI + 1024 + oc * 8) = w4;
        }
    }
}

constexpr int N_PHASES = 16;
__global__ void __launch_bounds__(512) hybrid_fwd(Args a) {
    extern __shared__ __attribute__((aligned(16))) unsigned char lds_raw[];
    LAS unsigned char* lds = (LAS unsigned char*)lds_raw;
    cg::grid_group grid = cg::this_grid();
    const int tid = threadIdx.x, lane = tid & 63, wave = __builtin_amdgcn_readfirstlane(tid >> 6);
    const int G = gridDim.x, bid = blockIdx.x;
    const int gw = bid * 8 + wave, NGW = G * 8;
    const int gtid = bid * 512 + tid, gthreads = G * 512;
    unsigned char* ws = a.ws;
    bf16_t* W1T = (bf16_t*)(ws + WS_W1T); bf16_t* W2T = (bf16_t*)(ws + WS_W2T); bf16_t* W3T = (bf16_t*)(ws + WS_W3T); bf16_t* W4T = (bf16_t*)(ws + WS_W4T);
    bf16_t* WSB = (bf16_t*)(ws + WS_WSB); float* LSE = (float*)(ws + WS_LSE);
    bf16_t* XN = (bf16_t*)(ws + WS_XN); bf16_t* X1 = (bf16_t*)(ws + WS_X1); bf16_t* Z1 = (bf16_t*)(ws + WS_Z1);
    bf16_t* QKV = (bf16_t*)(ws + WS_QKV); bf16_t* Y2 = (bf16_t*)(ws + WS_Y2); bf16_t* GBb = (bf16_t*)(ws + WS_GB);
    bf16_t* Y1 = (bf16_t*)a.out;
    bf16_t* Ob = (bf16_t*)a.out;
    bf16_t* ZC = (bf16_t*)((unsigned char*)a.out + 32 * MiB);
    const int lo = a.ph_lo, hi = a.ph_hi;
#define IN(k) (lo <= (k) && (k) < hi)
    volatile LAS unsigned* MISC = (volatile LAS unsigned*)(lds + MISC_OFF);
    if (tid < 32) MISC[tid] = 0u;
    __syncthreads();
    const XcdBarrier gbar = xcd_barrier_post((unsigned*)(ws + WS_BAR), MISC + 8);
    if (a.ph_hi > 1000) grid.sync();
#define GSYNC() xcd_barrier(gbar)
#define SYNC(k) do { if (IN(k) && IN((k) + 1)) GSYNC(); } while (0)

    if (IN(0)) {
        for (int it = bid; it < 256; it += G) fold_item(a.even_w_in, a.even_pool_w, W1T, (LAS float*)lds, it, tid);
        __syncthreads();
        LAS float* scr = (LAS float*)(lds + wave * 16384);
        constexpr int I1 = 16 * 128, I2 = 0, I3 = 0, ITOT = I1;
#define T_DECODE(it_, T_) do { int r_ = (it_); \
            if (r_ < I1) { const int kb = r_ / 128, nbk = r_ % 128; T_ = TItem{a.even_w_in, W1T, EVEN_IN, DM, kb * 64, 1024 + nbk * 32, w1_dst_row(1024 + nbk * 32)}; } \
            else if ((r_ -= I1) < I2) { const int kb = r_ / 32, nbk = r_ % 32; T_ = TItem{a.even_w_out, W2T, DM, DI, kb * 64, nbk * 32, nbk * 32}; } \
            else if ((r_ -= I2) < I3) { const int kb = r_ / 448, nbk = r_ % 448; T_ = TItem{a.odd_w_in, W3T, ODD_IN, DM, kb * 64, nbk * 32, w3_dst_row(nbk * 32)}; } \
            else { r_ -= I3; const int kb = r_ / 32, nbk = r_ % 32; T_ = TItem{a.odd_w_out, W4T, DM, DI, kb * 64, nbk * 32, nbk * 32}; } } while (0)
        if (gw < ITOT) {
            TItem cur; f32x4 vc[8]; T_DECODE(gw, cur); titem_load(cur, vc, lane);
            for (int it = gw; it < ITOT; it += NGW) {
                TItem nxt = cur; f32x4 vn[8]; const bool has = it + NGW < ITOT;
                if (has) { T_DECODE(it + NGW, nxt); titem_load(nxt, vn, lane); }
                titem_finish(cur, vc, scr, lane);
                if (has) { cur = nxt;
#pragma unroll
                    for (int i = 0; i < 8; ++i) vc[i] = vn[i]; }
            }
        }
#undef T_DECODE
        for (int i = gtid; i < 4 * 128 * 128; i += gthreads) { const int tt = (i >> 7) & 127, ss = i & 127; const float v = (ss <= tt) ? a.even_ws[i] : 0.f; WSB[i] = (bf16_t)(cvt_pk_bf16(v, 0.f) & 0xffffu); }
        for (int m = gw; m < M_TOK; m += 2 * NGW) rms_row2_bf16(a.x + (size_t)m * DM, a.x + (size_t)(m + NGW) * DM, a.even_norm, XN, m, m + NGW, lane);
    }
    SYNC(0);
#ifdef EXP_BAR
    for (int q = 0; q < 10; ++q) GSYNC();
#endif
    if (IN(1)) { pg8::Gemm g{XN, W1T, M_TOK, EVEN_IN, DM}; pg8::StaticOrder S; S.init(M_TOK, EVEN_IN, G, bid); pg8::EpiEven E{Z1}; pg8::gemm_phase(lds, g, S, E, NoPend{}); }
    xcd_arrive(gbar); seam_convert<1>(a.even_w_out, a.odd_w_in, a.odd_w_out, W2T, W3T, W4T, (LAS float*)(lds + wave * 16384), gw, NGW, lane); xcd_wait(gbar);
    if (IN(2)) { ya_phase(Z1, a.even_pool_scale, Y1, gw, NGW, lane); yb_phase(lds, Z1, WSB, a.even_bs, Y1, G, bid); }
    xcd_arrive(gbar); seam_convert<2>(a.even_w_out, a.odd_w_in, a.odd_w_out, W2T, W3T, W4T, (LAS float*)(lds + wave * 16384), gw, NGW, lane);
    if (IN(3)) { pg8::Gemm g{Y1, W2T, M_TOK, DM, DI}; pg8::StaticOrder S; S.init(M_TOK, DM, G, bid);
        pg8::EpiResNorm<true> E{a.x, nullptr, X1, XN, nullptr, a.odd_norm, pg8::PanelSq{(float*)(ws + WS_XB0), (unsigned*)(ws + WS_CNT0)}}; pg8::gemm_phase(lds, g, S, E, EarlyPend{&gbar}); }
    xcd_arrive(gbar); seam_convert<3>(a.even_w_out, a.odd_w_in, a.odd_w_out, W2T, W3T, W4T, (LAS float*)(lds + wave * 16384), gw, NGW, lane); xcd_wait(gbar);
    if (IN(5)) { pg8::Gemm g{XN, W3T, M_TOK, 3072, DM}; pg8::StaticOrder S; S.init(M_TOK, 3072, G, bid); pg8::EpiBf16 E{QKV, 3072}; pg8::gemm_phase(lds, g, S, E, NoPend{}); }
    xcd_arrive(gbar); seam_convert<4>(a.even_w_out, a.odd_w_in, a.odd_w_out, W2T, W3T, W4T, (LAS float*)(lds + wave * 16384), gw, NGW, lane); xcd_wait(gbar);
    attn_group_phase<0>(lds, QKV, Ob, LSE, G, bid);
    xcd_arrive(gbar);
    { pg8::Gemm g{XN, W3T + (size_t)3072 * DM, M_TOK, 3072, DM}; pg8::StaticOrder S; S.init(M_TOK, 3072, G, bid); pg8::EpiBf16 E{QKV, 3072}; pg8::gemm_phase(lds, g, S, E, BarPend{&gbar}); }
    xcd_arrive(gbar); seam_convert<5>(a.even_w_out, a.odd_w_in, a.odd_w_out, W2T, W3T, W4T, (LAS float*)(lds + wave * 16384), gw, NGW, lane); xcd_wait(gbar);
    attn_group_phase<1>(lds, QKV, Ob, LSE, G, bid);
    xcd_arrive(gbar);
    { pg8::Gemm g{XN, W3T + (size_t)2 * 3072 * DM, M_TOK, 5120, DM}; pg8::StaticOrder S; S.init(M_TOK, 5120, G, bid);
        pg8::EpiQkvZc E{pg8::EpiBf16{QKV, 3072}, pg8::EpiPair{ZC, GBb}}; pg8::gemm_phase(lds, g, S, E, BarPend{&gbar}); }
    GSYNC();
    attn_group_phase<2>(lds, QKV, Ob, LSE, G, bid);
    xcd_arrive(gbar);
    { pg8::Gemm g{XN, W3T + (size_t)11264 * DM, M_TOK, 3072, DM}; pg8::StaticOrder S; S.init(M_TOK, 3072, G, bid);
        pg8::EpiGcGb E{pg8::EpiGateMul{Ob, 1024, Y2, DI}, pg8::EpiGateConv{ZC, a.odd_conv_w, Y2}}; pg8::gemm_phase(lds, g, S, E, BarPend{&gbar}); }
    xcd_arrive(gbar);
    if (IN(14)) { pg8::Gemm g{Y2, W4T, M_TOK, DM, DI}; pg8::StaticOrder S; S.init(M_TOK, DM, G, bid);
        pg8::EpiResNorm<false> E{nullptr, X1, nullptr, nullptr, a.out, a.final_norm, pg8::PanelSq{(float*)(ws + WS_XB1), (unsigned*)(ws + WS_CNT1)}}; pg8::gemm_phase(lds, g, S, E, EarlyPend{&gbar}); }
#undef IN
#undef SYNC
}

extern "C" void kernel_launch(void* const* d_in, const int* in_sizes, int n_in, void* d_out, int out_size, void* d_ws, size_t ws_size, hipStream_t stream) {
    static int grid = 0;
    if (grid == 0) {
        int dev = 0, cus = 0, per_cu = 0;
        hipGetDevice(&dev);
        hipDeviceGetAttribute(&cus, hipDeviceAttributeMultiprocessorCount, dev);
        hipFuncSetAttribute((const void*)hybrid_fwd, hipFuncAttributeMaxDynamicSharedMemorySize, LDS_BYTES);
        if (hipOccupancyMaxActiveBlocksPerMultiprocessor(&per_cu, (const void*)hybrid_fwd, 512, LDS_BYTES) != hipSuccess || per_cu < 1) per_cu = 1;
        (void)hipGetLastError();
        grid = cus * per_cu;
        if (grid <= 0) grid = 256;
    }
    Args a{};
    a.x = (const float*)d_in[0]; a.even_norm = (const float*)d_in[1]; a.even_w_in = (const float*)d_in[2]; a.even_pool_w = (const float*)d_in[3];
    a.even_pool_scale = (const float*)d_in[4]; a.even_ws = (const float*)d_in[5]; a.even_bs = (const float*)d_in[6]; a.even_w_out = (const float*)d_in[7];
    a.odd_norm = (const float*)d_in[8]; a.odd_w_in = (const float*)d_in[9]; a.odd_conv_w = (const float*)d_in[10]; a.odd_w_out = (const float*)d_in[11];
    a.final_norm = (const float*)d_in[12];
    a.out = (float*)d_out; a.ws = (unsigned char*)d_ws; a.ph_lo = 0; a.ph_hi = N_PHASES;
    (void)hipMemsetAsync((char*)d_ws + WS_BAR, 0, 49152, stream);
    void* args[] = {&a};
    hipError_t e = hipLaunchCooperativeKernel((const void*)hybrid_fwd, dim3(grid), dim3(512), args, LDS_BYTES, stream);
    if (e != hipSuccess) fprintf(stderr, "cooperative launch failed: %s (grid %d)\n", hipGetErrorString(e), grid);
}
```
